# Optimizing an MI355X kernel written in HIP

```python
import jax
import jax.numpy as jnp
from jax import lax
import numpy as np


D_MODEL = 1024
BATCH = 4
SEQ = 8192
DEPTH = 2
DEC_BATCH = 1
DEC_SEQ = 16384
PAST_LEN = 128

PLE_DIM = 256
GRID_W = 64
N_MIXERS = 4
D_MIX = D_MODEL
W_GROUP = D_MIX // N_MIXERS
HEAD_DIM = 64
N_HEADS_GROUP = W_GROUP // HEAD_DIM
LRU_BLOCK = W_GROUP // N_HEADS_GROUP
LRU_C = 8.0
SHORT_CONV = 4
SHORT_CONV_LEFT = 2
CHUNK = 64
ROPE_BASE = 10000.0
NA_KH = 8
NA_KW = 16
D_FF = 2816
FFN_CONV = 3
EPS = 1e-6
SPLIT_SIZES = (W_GROUP, W_GROUP, 3 * W_GROUP, W_GROUP, 2 * N_HEADS_GROUP, 2 * N_HEADS_GROUP, 3 * W_GROUP, W_GROUP, 3 * W_GROUP)
IN_COLS = 13 * W_GROUP + 4 * N_HEADS_GROUP

kernel_name = 'hybrid_bidir_encoder_parallel_heads'


def rms_norm(x, gain):
    xf = x.astype(jnp.float32)
    y = xf * lax.rsqrt(jnp.mean(xf * xf, axis=-1, keepdims=True) + EPS)
    return (y * gain.astype(jnp.float32)).astype(x.dtype)


def head_layer_norm(t, gain):
    mu = jnp.mean(t, axis=-1, keepdims=True)
    tc = t - mu
    return tc * lax.rsqrt(jnp.mean(tc * tc, axis=-1, keepdims=True) + EPS) * gain


def l2_normalize(t):
    return t * lax.rsqrt(jnp.sum(t * t, axis=-1, keepdims=True) + EPS)


def depthwise_conv(x, w, left):
    k = w.shape[0]
    s = x.shape[1]
    xp = jnp.pad(x, ((0, 0), (left, k - 1 - left), (0, 0)))
    out = xp[:, 0:s] * w[0]
    for j in range(1, k):
        out = out + xp[:, j:j + s] * w[j]
    return out


def flip_seq(t):
    return jnp.flip(t, axis=1)


def to_chunks(t):
    b, s, h = t.shape[:3]
    return jnp.moveaxis(t.reshape(b, s // CHUNK, CHUNK, h, -1), 3, 1)


def from_chunks(t):
    b, h, n, c, d = t.shape
    return jnp.moveaxis(t, 1, 3).reshape(b, n * c, h, d)


def rotary(t):
    s, d = t.shape[1], t.shape[-1]
    half = d // 2
    inv_freq = ROPE_BASE ** (-jnp.arange(half, dtype=jnp.float32) / half)
    ang = jnp.arange(s, dtype=jnp.float32)[:, None] * inv_freq[None, :]
    cos = jnp.cos(ang)[None, :, None, :]
    sin = jnp.sin(ang)[None, :, None, :]
    t1, t2 = t[..., :half], t[..., half:]
    return jnp.concatenate([t1 * cos - t2 * sin, t1 * sin + t2 * cos], axis=-1)


def linear_combine(left, right):
    a_l, b_l = left
    a_r, b_r = right
    return a_l * a_r, a_r * b_l + b_r


def rglru_direction(x, w_r, b_r, w_i, b_i, lam, reverse):
    b, s, w = x.shape
    xb = x.reshape(b, s, N_HEADS_GROUP, LRU_BLOCK)
    r = jax.nn.sigmoid(jnp.einsum('bshi,hij->bshj', xb, w_r).reshape(b, s, w) + b_r)
    i = jax.nn.sigmoid(jnp.einsum('bshi,hij->bshj', xb, w_i).reshape(b, s, w) + b_i)
    log_a = -LRU_C * r * jax.nn.softplus(-lam)
    gated_x = jnp.sqrt(-jnp.expm1(2.0 * log_a)) * (i * x)
    _, h = lax.associative_scan(linear_combine, (jnp.exp(log_a), gated_x), reverse=reverse, axis=1)
    return h


def gated_delta_chunked(q, k, v, beta, g):
    q, k, v = to_chunks(q), to_chunks(k), to_chunks(v)
    beta = to_chunks(beta[..., None])[..., 0]
    gcum = jnp.cumsum(to_chunks(g[..., None])[..., 0], axis=-1)
    c = CHUNK
    lower = jnp.tril(jnp.ones((c, c), dtype=bool))
    strict = jnp.tril(jnp.ones((c, c), dtype=bool), -1)
    decay = jnp.exp(jnp.where(lower, gcum[..., :, None] - gcum[..., None, :], -jnp.inf))
    kk = jnp.einsum('bhnid,bhnjd->bhnij', k, k)
    l_mat = jnp.where(strict, beta[..., :, None] * kk * decay, 0.0)
    dv = v.shape[-1]
    rhs = jnp.concatenate([v * beta[..., None], k * (beta * jnp.exp(gcum))[..., None]], axis=-1)
    sol = lax.linalg.triangular_solve(l_mat, rhs, left_side=True, lower=True, unit_diagonal=True)
    u_val, w_key = sol[..., :dv], sol[..., dv:]
    attn = jnp.einsum('bhnid,bhnjd->bhnij', q, k) * decay
    q_g = q * jnp.exp(gcum)[..., None]
    g_last = gcum[..., -1]
    k_g = k * jnp.exp(g_last[..., None] - gcum)[..., None]

    def step(state, xs):
        u_n, w_n, q_n, a_n, k_n, gl_n = xs
        v_new = u_n - jnp.einsum('bhck,bhkv->bhcv', w_n, state)
        o_n = jnp.einsum('bhck,bhkv->bhcv', q_n, state) + jnp.einsum('bhij,bhjv->bhiv', a_n, v_new)
        state = state * jnp.exp(gl_n)[..., None, None] + jnp.einsum('bhck,bhcv->bhkv', k_n, v_new)
        return state, o_n

    xs = tuple(jnp.moveaxis(t, 2, 0) for t in (u_val, w_key, q_g, attn, k_g, g_last))
    b, h, _, _, dk = q.shape
    state0 = jnp.zeros((b, h, dk, dv), q.dtype)
    _, o = lax.scan(step, state0, xs)
    return from_chunks(jnp.moveaxis(o, 0, 2))


def retention_chunked(q, k, v, log_gamma):
    q, k, v = to_chunks(q), to_chunks(k), to_chunks(v)
    c = CHUNK
    pos = jnp.arange(c, dtype=jnp.float32)
    lower = jnp.tril(jnp.ones((c, c), dtype=bool))
    lg = log_gamma[:, None]
    dmask = jnp.exp(jnp.where(lower, (pos[:, None] - pos[None, :]) * log_gamma[:, None, None], -jnp.inf))
    scores = jnp.einsum('bhnid,bhnjd->bhnij', q, k) * dmask[None, :, None]
    inner = jnp.einsum('bhnij,bhnje->bhnie', scores, v)
    q_dec = q * jnp.exp((pos[None, :] + 1.0) * lg)[None, :, None, :, None]
    k_dec = k * jnp.exp((c - 1.0 - pos[None, :]) * lg)[None, :, None, :, None]
    kv = jnp.einsum('bhncd,bhnce->nbhde', k_dec, v)
    chunk_decay = jnp.exp(c * log_gamma)[None, :, None, None]

    def step(state, kv_n):
        return state * chunk_decay + kv_n, state

    _, prev = lax.scan(step, jnp.zeros_like(kv[0]), kv)
    cross = jnp.einsum('bhncd,nbhde->bhnce', q_dec, prev)
    return from_chunks(inner + cross)


def neighborhood_attention(q, k, v, rpb):
    b, s, h, d = q.shape
    rows = s // GRID_W
    kh = min(NA_KH, rows)
    qg = q.reshape(b, rows, GRID_W, h, d)
    kg = k.reshape(b, rows, GRID_W, h, d)
    vg = v.reshape(b, rows, GRID_W, h, d)
    cols = jnp.arange(GRID_W)
    c0 = jnp.clip(cols - NA_KW // 2, 0, GRID_W - NA_KW)
    col_idx = c0[:, None] + jnp.arange(NA_KW)[None, :]
    dc = col_idx - cols[:, None] + (NA_KW - 1)
    scale = d ** -0.5

    def row_block(r):
        r0 = jnp.clip(r - kh // 2, 0, rows - kh)
        k_win = lax.dynamic_slice_in_dim(kg, r0, kh, axis=1)[:, :, col_idx]
        v_win = lax.dynamic_slice_in_dim(vg, r0, kh, axis=1)[:, :, col_idx]
        q_r = lax.dynamic_index_in_dim(qg, r, axis=1, keepdims=False)
        dr = r0 + jnp.arange(kh) - r + (NA_KH - 1)
        bias = rpb[:, dr[:, None, None], dc[None, :, :]]
        scores = jnp.einsum('bchd,bkcwhd->bhckw', q_r, k_win) * scale + jnp.transpose(bias, (0, 2, 1, 3))[None]
        probs = jax.nn.softmax(scores.reshape(b, h, GRID_W, kh * NA_KW), axis=-1).reshape(scores.shape)
        return jnp.einsum('bhckw,bkcwhd->bchd', probs, v_win)

    out = lax.map(row_block, jnp.arange(rows))
    return jnp.moveaxis(out, 0, 1).reshape(b, s, h, d)


def encoder_layer(x, p_l, lw):
    b, s, _ = x.shape
    f32 = jnp.float32
    heads = lambda t: t.reshape(b, s, N_HEADS_GROUP, HEAD_DIM)
    hn = rms_norm(x, lw['norm1'])
    u = (hn @ lw['w_in']).astype(f32)
    xa, ya, qkv_b, z_b, beta_b, alpha_b, qkv_c, gate_c, qkv_d = jnp.split(u, np.cumsum(SPLIT_SIZES)[:-1].tolist(), axis=-1)

    xa = depthwise_conv(xa, lw['conv_a_w'].astype(f32), SHORT_CONV_LEFT) + lw['conv_a_b'].astype(f32)
    wr, br, wi, bi, lam = (lw[n].astype(f32) for n in ('lru_wr', 'lru_br', 'lru_wi', 'lru_bi', 'lru_lambda'))
    h_a = rglru_direction(xa, wr[0], br[0], wi[0], bi[0], lam[0], False) + rglru_direction(xa, wr[1], br[1], wi[1], bi[1], lam[1], True)
    out_a = h_a * jax.nn.gelu(ya)

    qkv_b = jax.nn.silu(depthwise_conv(qkv_b, lw['gdn_conv'].astype(f32), SHORT_CONV_LEFT))
    q_b, k_b, v_b = (heads(t) for t in jnp.split(qkv_b, 3, axis=-1))
    q_b = l2_normalize(q_b) * (HEAD_DIM ** -0.5)
    k_b = l2_normalize(k_b)
    beta = jax.nn.sigmoid(beta_b).reshape(b, s, 2, N_HEADS_GROUP)
    g = -jnp.exp(lw['gdn_a_log'].astype(f32)) * jax.nn.softplus(alpha_b.reshape(b, s, 2, N_HEADS_GROUP) + lw['gdn_dt_bias'].astype(f32))
    o_b = gated_delta_chunked(q_b, k_b, v_b, beta[:, :, 0], g[:, :, 0]) + flip_seq(gated_delta_chunked(flip_seq(q_b), flip_seq(k_b), flip_seq(v_b), flip_seq(beta[:, :, 1]), flip_seq(g[:, :, 1])))
    out_b = rms_norm(o_b, lw['gdn_norm']) * jax.nn.silu(heads(z_b))

    q_c, k_c, v_c = (heads(t) for t in jnp.split(qkv_c, 3, axis=-1))
    q_c = rotary(q_c)
    k_c = rotary(k_c) * (HEAD_DIM ** -0.5)
    log_gamma = jnp.log1p(-jnp.exp2(-lw['ret_decay'].astype(f32)))
    o_c = retention_chunked(q_c, k_c, v_c, log_gamma[0]) + flip_seq(retention_chunked(flip_seq(q_c), flip_seq(k_c), flip_seq(v_c), log_gamma[1]))
    out_c = head_layer_norm(o_c, lw['ret_norm'].astype(f32)) * jax.nn.silu(heads(gate_c))

    q_d, k_d, v_d = (heads(t) for t in jnp.split(qkv_d, 3, axis=-1))
    q_d = rms_norm(q_d, lw['na_qnorm'])
    k_d = rms_norm(k_d, lw['na_knorm'])
    out_d = neighborhood_attention(q_d, k_d, v_d, lw['na_rpb'].astype(f32))

    mix = jnp.concatenate([out_a, out_b.reshape(b, s, W_GROUP), out_c.reshape(b, s, W_GROUP), out_d.reshape(b, s, W_GROUP)], axis=-1)
    x = x + mix.astype(x.dtype) @ lw['w_out']

    h2 = rms_norm(x, lw['norm2'])
    gate = depthwise_conv(h2 @ lw['ffn_wg'], lw['ffn_conv_w'], FFN_CONV // 2) + lw['ffn_conv_b']
    x = x + (jax.nn.gelu(gate) * (h2 @ lw['ffn_wu'])) @ lw['ffn_wd']

    h3 = rms_norm(x, lw['norm3'])
    x = x + jax.nn.sigmoid(h3 @ lw['ple_gate']) * (p_l @ lw['ple_proj'])
    return x


def setup_inputs(seed: int = 0) -> dict:
    key = jax.random.key(seed)
    ks = iter(jax.random.split(key, 40))
    H = N_HEADS_GROUP

    def nrm(shape, scale):
        return jax.random.normal(next(ks), shape, jnp.float32) * scale

    def gain(shape):
        return 1.0 + nrm(shape, 0.02)

    x_prompt = nrm((BATCH, SEQ, D_MODEL), 1.0)
    x_sample = nrm((DEC_BATCH, DEC_SEQ, D_MODEL), 1.0)
    p_prompt = nrm((DEPTH, BATCH, SEQ, PLE_DIM), 1.0)
    p_sample = nrm((DEPTH, DEC_BATCH, DEC_SEQ, PLE_DIM), 1.0)
    norm1 = gain((DEPTH, D_MODEL))
    norm2 = gain((DEPTH, D_MODEL))
    norm3 = gain((DEPTH, D_MODEL))
    w_in = nrm((DEPTH, D_MODEL, IN_COLS), D_MODEL ** -0.5)
    w_out = nrm((DEPTH, D_MIX, D_MODEL), D_MIX ** -0.5)
    conv_a_w = nrm((DEPTH, SHORT_CONV, W_GROUP), SHORT_CONV ** -0.5)
    conv_a_b = nrm((DEPTH, W_GROUP), 0.02)
    lru_wr = nrm((DEPTH, 2, H, LRU_BLOCK, LRU_BLOCK), LRU_BLOCK ** -0.5)
    lru_br = nrm((DEPTH, 2, W_GROUP), 0.02)
    lru_wi = nrm((DEPTH, 2, H, LRU_BLOCK, LRU_BLOCK), LRU_BLOCK ** -0.5)
    lru_bi = nrm((DEPTH, 2, W_GROUP), 0.02)
    a_target = jax.random.uniform(next(ks), (DEPTH, 2, W_GROUP), jnp.float32, minval=0.9, maxval=0.999)
    sig = a_target ** (1.0 / LRU_C)
    lru_lambda = jnp.log(sig) - jnp.log1p(-sig)
    gdn_conv = nrm((DEPTH, SHORT_CONV, 3 * W_GROUP), SHORT_CONV ** -0.5)
    gdn_a_log = jnp.log(jax.random.uniform(next(ks), (DEPTH, 2, H), jnp.float32, minval=1.0, maxval=16.0))
    dt = jnp.exp(jax.random.uniform(next(ks), (DEPTH, 2, H), jnp.float32, minval=float(np.log(1e-3)), maxval=float(np.log(1e-1))))
    gdn_dt_bias = dt + jnp.log(-jnp.expm1(-dt))
    gdn_norm = gain((DEPTH, HEAD_DIM))
    ret_decay = 5.0 + jnp.arange(H, dtype=jnp.float32)[None, None, :] + nrm((DEPTH, 2, H), 0.1)
    ret_norm = gain((DEPTH, HEAD_DIM))
    na_qnorm = gain((DEPTH, HEAD_DIM))
    na_knorm = gain((DEPTH, HEAD_DIM))
    na_rpb = nrm((DEPTH, H, 2 * NA_KH - 1, 2 * NA_KW - 1), 0.02)
    ffn_wg = nrm((DEPTH, D_MODEL, D_FF), D_MODEL ** -0.5)
    ffn_wu = nrm((DEPTH, D_MODEL, D_FF), D_MODEL ** -0.5)
    ffn_conv_w = nrm((DEPTH, FFN_CONV, D_FF), FFN_CONV ** -0.5)
    ffn_conv_b = nrm((DEPTH, D_FF), 0.02)
    ffn_wd = nrm((DEPTH, D_FF, D_MODEL), D_FF ** -0.5)
    ple_proj = nrm((DEPTH, PLE_DIM, D_MODEL), PLE_DIM ** -0.5)
    ple_gate = nrm((DEPTH, D_MODEL, D_MODEL), D_MODEL ** -0.5)
    return {'x_prompt': x_prompt, 'x_sample': x_sample, 'p_prompt': p_prompt, 'p_sample': p_sample,
            'norm1': norm1, 'norm2': norm2, 'norm3': norm3, 'w_in': w_in, 'w_out': w_out,
            'conv_a_w': conv_a_w, 'conv_a_b': conv_a_b, 'lru_wr': lru_wr, 'lru_br': lru_br,
            'lru_wi': lru_wi, 'lru_bi': lru_bi, 'lru_lambda': lru_lambda,
            'gdn_conv': gdn_conv, 'gdn_a_log': gdn_a_log, 'gdn_dt_bias': gdn_dt_bias, 'gdn_norm': gdn_norm,
            'ret_decay': ret_decay, 'ret_norm': ret_norm,
            'na_qnorm': na_qnorm, 'na_knorm': na_knorm, 'na_rpb': na_rpb,
            'ffn_wg': ffn_wg, 'ffn_wu': ffn_wu, 'ffn_conv_w': ffn_conv_w, 'ffn_conv_b': ffn_conv_b, 'ffn_wd': ffn_wd,
            'ple_proj': ple_proj, 'ple_gate': ple_gate}


def reference(x_prompt, x_sample, p_prompt, p_sample, norm1, norm2, norm3, w_in, w_out,
              conv_a_w, conv_a_b, lru_wr, lru_br, lru_wi, lru_bi, lru_lambda,
              gdn_conv, gdn_a_log, gdn_dt_bias, gdn_norm, ret_decay, ret_norm,
              na_qnorm, na_knorm, na_rpb, ffn_wg, ffn_wu, ffn_conv_w, ffn_conv_b, ffn_wd,
              ple_proj, ple_gate):
    def run_trunk(x, p):
        for i in range(DEPTH):
            lw = {'norm1': norm1[i], 'norm2': norm2[i], 'norm3': norm3[i], 'w_in': w_in[i], 'w_out': w_out[i],
                  'conv_a_w': conv_a_w[i], 'conv_a_b': conv_a_b[i], 'lru_wr': lru_wr[i], 'lru_br': lru_br[i],
                  'lru_wi': lru_wi[i], 'lru_bi': lru_bi[i], 'lru_lambda': lru_lambda[i],
                  'gdn_conv': gdn_conv[i], 'gdn_a_log': gdn_a_log[i], 'gdn_dt_bias': gdn_dt_bias[i], 'gdn_norm': gdn_norm[i],
                  'ret_decay': ret_decay[i], 'ret_norm': ret_norm[i],
                  'na_qnorm': na_qnorm[i], 'na_knorm': na_knorm[i], 'na_rpb': na_rpb[i],
                  'ffn_wg': ffn_wg[i], 'ffn_wu': ffn_wu[i], 'ffn_conv_w': ffn_conv_w[i], 'ffn_conv_b': ffn_conv_b[i],
                  'ffn_wd': ffn_wd[i], 'ple_proj': ple_proj[i], 'ple_gate': ple_gate[i]}
            x = encoder_layer(x, p[i], lw)
        return x

    y_prompt = run_trunk(x_prompt, p_prompt)
    y_sample = run_trunk(x_sample, p_sample)
    return (y_prompt, y_sample)
```

```cpp
#include <hip/hip_runtime.h>
#include <hip/hip_cooperative_groups.h>
#include <cstdio>
#include <cstdint>
namespace cg = cooperative_groups;

typedef unsigned short bf16_t;
typedef short bf16x8 __attribute__((ext_vector_type(8)));
typedef short bf16x4 __attribute__((ext_vector_type(4)));
typedef float f32x4 __attribute__((ext_vector_type(4)));
typedef float f32x2 __attribute__((ext_vector_type(2)));
typedef unsigned u32x4 __attribute__((ext_vector_type(4)));
typedef unsigned u32x2 __attribute__((ext_vector_type(2)));

constexpr int M_TOK = 49152, DM = 1024, LDU = 3328, DFF = 2816, PLED = 256, NCHUNK = 768, INC = 3344;
constexpr int MH = 16384;
constexpr float EPS = 1e-6f;
constexpr int UC_YA = 0, UC_ZB = 256, UC_GC = 512, UC_QD = 768, UC_XA = 1024, UC_QB = 1280, UC_KB = 1536, UC_VB = 1792,
              UC_QC = 2048, UC_KC = 2304, UC_VC = 2560, UC_KD = 2816, UC_VD = 3072;
constexpr size_t MiB = 1u << 20;
constexpr size_t WS_RS = 0;
constexpr size_t WS_DEC = 256 * 1024;
constexpr size_t WS_BAR = 384 * 1024;
constexpr size_t WS_LRU = 512 * 1024;
constexpr size_t WS_BA = 1 * MiB;
constexpr size_t WS_WIN = 4 * MiB, WS_WOUT = WS_WIN + 6656 * 1024, WS_WGU = WS_WOUT + 2 * MiB, WS_WD = WS_WGU + 11 * MiB,
                 WS_WPG = WS_WD + 5632 * 1024, WS_WPP = WS_WPG + 2 * MiB;
constexpr size_t WS_U = 32 * MiB;
constexpr size_t WS_XB = 344 * MiB;
constexpr size_t WS_T = 440 * MiB;
constexpr size_t WS_END = 512 * MiB;
constexpr size_t WS_MN = WS_XB;
constexpr size_t WS_KV = WS_XB + 96 * MiB;
constexpr size_t WS_ASUM = WS_XB + 144 * MiB;
constexpr size_t WS_HB = WS_XB + 148 * MiB;
constexpr size_t WS_SS2 = WS_XB + 152 * MiB, WS_SS3 = WS_XB + 155 * MiB;
constexpr size_t WS_G = WS_U, WS_UP = WS_U + 96 * MiB;
constexpr size_t WS_P = WS_U, WS_PB = WS_T;

__device__ __forceinline__ unsigned f2bf(float f) { unsigned u = __builtin_bit_cast(unsigned, f); return (u + 0x7fffu + ((u >> 16) & 1u)) >> 16; }
__device__ __forceinline__ unsigned pk2(float lo, float hi) { return f2bf(lo) | (f2bf(hi) << 16); }
__device__ __forceinline__ float bf2f(unsigned short b) { return __builtin_bit_cast(float, (unsigned)b << 16); }
__device__ __forceinline__ float bflo(unsigned w) { return __builtin_bit_cast(float, w << 16); }
__device__ __forceinline__ float bfhi(unsigned w) { return __builtin_bit_cast(float, w & 0xffff0000u); }
__device__ __forceinline__ float shx(float v, int mask, int lane) { return __builtin_bit_cast(float, __builtin_amdgcn_ds_bpermute(((lane ^ mask) & 63) << 2, __builtin_bit_cast(int, v))); }
__device__ __forceinline__ float wave_sum(float v, int lane) {
#pragma unroll
    for (int o = 1; o < 64; o <<= 1) v += shx(v, o, lane);
    return v;
}
__device__ __forceinline__ float sigmoidf_(float x) { return 1.f / (1.f + __expf(-x)); }
__device__ __forceinline__ float siluf_(float x) { return x / (1.f + __expf(-x)); }
__device__ __forceinline__ float gelu_tanh(float x) { const float u = 0.7978845608028654f * (x + 0.044715f * x * x * x); return x / (1.f + __expf(-2.f * u)); }
__device__ __forceinline__ float log1p_small(float x) { return x * (1.f + x * (-0.5f + x * (0.33333334f + x * (-0.25f + x * (0.2f + x * (-0.16666667f + x * 0.14285715f)))))); }
__device__ __forceinline__ float softplusf_(float x) { if (x > 20.f) return x; const float e = __expf(x); return e < 0.05f ? log1p_small(e) : __logf(1.f + e); }
__device__ __forceinline__ float neg_expm1(float t) { return fabsf(t) < 0.25f ? -t * (1.f + t * (0.5f + t * (0.16666667f + t * (0.041666668f + t * (0.008333334f + t * (0.0013888889f + t * 0.0001984127f)))))) : 1.f - __expf(t); }
__device__ __forceinline__ int seq_start_tok(int t) { return t < 32768 ? (t & ~8191) : 32768; }
__device__ __forceinline__ int seq_end_tok(int t) { return t < 32768 ? (t & ~8191) + 8192 : 49152; }
__device__ __forceinline__ f32x4 mfma16(bf16x8 a, bf16x8 b, f32x4 c) { return __builtin_amdgcn_mfma_f32_16x16x32_bf16(a, b, c, 0, 0, 0); }
extern __shared__ __attribute__((aligned(16))) unsigned char lds_dyn[];
#define LDSW() asm volatile("s_waitcnt lgkmcnt(0)" ::: "memory")

namespace pg8 {
#define PG8_LAS __attribute__((address_space(3)))
constexpr int BM = 256, BK = 64, HALF = 128, HTB = HALF * BK * 2, NXCD = 8, WGM = 8;
__host__ __device__ __forceinline__ int lds_byte(int r, int c) { const int st = (r >> 4) * 2 + (c >> 5), rr = r & 15, cc = c & 31, ob = rr * 64 + cc * 2; return st * 1024 + (ob ^ (((ob >> 9) & 1) << 5)); }
__host__ __device__ __forceinline__ void stage_rc(int b, int& R, int& C) { const int st = b / 1024, sb = b % 1024, swz = sb ^ (((sb >> 9) & 1) << 5); R = (st >> 1) * 16 + swz / 64; C = (st & 1) * 32 + (swz % 64) / 2; }
__host__ __device__ __forceinline__ int perm32(int rho) { const int n = rho >> 4, i = rho & 15; return 8 * (i >> 2) + 4 * n + (i & 3); }
struct Unit { int pm, pn; };
struct Gemm { const bf16_t* A; const bf16_t* Bt; int M, N, K, lda; };
struct StaticOrder {
    int nM, nN, nwg, G, c;
    __host__ __device__ void init(int M, int N, int G_, int c_) { nM = M / BM; nN = N / BM; nwg = nM * nN; G = G_; c = c_; }
    __host__ __device__ bool next(int i, Unit& u) const {
        const long L = (long)i * G + c; if (L >= nwg) return false;
        int wgid = (int)L; { const int q = nwg / NXCD, r = nwg % NXCD, xcd = wgid % NXCD, off = wgid / NXCD; wgid = (xcd < r ? xcd * (q + 1) : r * (q + 1) + (xcd - r) * q) + off; }
        const int nig = WGM * nN, gid = wgid / nig, fm = gid * WGM, gsz = (nM - fm) < WGM ? (nM - fm) : WGM;
        u.pm = fm + ((wgid % nig) % gsz); u.pn = (wgid % nig) / gsz; return true;
    }
    __device__ __forceinline__ void a_ready(const Unit&) const {}
    __device__ __forceinline__ void done(const Unit&) const {}
};
__device__ __forceinline__ unsigned cvt_pk_bf16(float lo, float hi) { unsigned r; asm("v_cvt_pk_bf16_f32 %0, %1, %2" : "=v"(r) : "v"(lo), "v"(hi)); return r; }

template <class Epi, class Sched, bool ALIGN_EPI = false>
__device__ __forceinline__ void gemm_phase(PG8_LAS unsigned char* lds, const Gemm g, const Sched& S, const Epi& E, int tid_in) {
    int tidq = tid_in; asm volatile("" : "+v"(tidq));
    const int tid = tidq, wid = __builtin_amdgcn_readfirstlane(tid >> 6), lane = tid & 63, wr = wid >> 2, wc = wid & 3, fr = lane & 15, fq = lane >> 4;
    int Kq = g.K; asm volatile("" : "+s"(Kq));
    const int K = Kq, nt = K / BK, lda = g.lda;
    unsigned voffA[2], voffB[2];
#pragma unroll
    for (int i = 0; i < 2; ++i) { int R, C; stage_rc(tid * 16 + i * 8192, R, C); const int Rb = Epi::PERM ? ((R & ~31) + perm32(R & 31)) : R;
        voffA[i] = (unsigned)(R * lda + C) * 2u; voffB[i] = (unsigned)(Rb * K + C) * 2u; }
    const size_t kstep = (size_t)(BK * 2);
    const size_t hstepA = (size_t)HALF * lda * 2, hstepB = (size_t)HALF * K * 2;
    const size_t tstepA = 2 * hstepA, tstepB = 2 * hstepB;
    const unsigned ldsw = (unsigned)wid * 1024u;
    const int aoff = lds_byte(wr * 64 + fr, fq * 8), boff = lds_byte(wc * 32 + fr, fq * 8);
#define PG8_SA(b, h) (((b) * 2 + (h)) * HTB)
#define PG8_SB(b, h) ((4 + (b) * 2 + (h)) * HTB)
#define PG8_STAGE(bufoff, gbase, voff) do { _Pragma("unroll") for (int _i = 0; _i < 2; ++_i) \
        __builtin_amdgcn_global_load_lds((const unsigned*)((const char*)(gbase) + (voff)[_i]), (PG8_LAS unsigned*)(lds + (bufoff) + ldsw + _i * 8192), 16, 0, 0); } while (0)
#define PG8_LDA(dst, b, h) do { _Pragma("unroll") for (int m = 0; m < 4; ++m) _Pragma("unroll") for (int k = 0; k < 2; ++k) dst[m][k] = *(const PG8_LAS bf16x8*)(lds + PG8_SA(b, h) + aoff + m * 2048 + k * 1024); } while (0)
#define PG8_LDB(dst, b, h) do { _Pragma("unroll") for (int n = 0; n < 2; ++n) _Pragma("unroll") for (int k = 0; k < 2; ++k) dst[n][k] = *(const PG8_LAS bf16x8*)(lds + PG8_SB(b, h) + boff + n * 2048 + k * 1024); } while (0)
#define PG8_MMA(ai, bj, At, Bt) do { __builtin_amdgcn_s_setprio(1); _Pragma("unroll") for (int m = 0; m < 4; ++m) _Pragma("unroll") for (int n = 0; n < 2; ++n) _Pragma("unroll") for (int k = 0; k < 2; ++k) \
        acc[ai][bj][m][n] = __builtin_amdgcn_mfma_f32_16x16x32_bf16(Bt[n][k], At[m][k], acc[ai][bj][m][n], 0, 0, 0); __builtin_amdgcn_s_setprio(0); } while (0)
#define PG8_WAIT_V(n) asm volatile("s_waitcnt vmcnt(" #n ")" ::: "memory")
#define PG8_WAIT_L(n) asm volatile("s_waitcnt lgkmcnt(" #n ")" ::: "memory")
#define PG8_BAR __builtin_amdgcn_s_barrier()
#define PG8_SCHED __builtin_amdgcn_sched_barrier(0)
    Unit cur, nxt; int ui = 0;
    if (!S.next(0, cur)) return;
    f32x4 acc[2][2][4][2];
#pragma unroll
    for (int a = 0; a < 2; ++a)
#pragma unroll
        for (int b = 0; b < 2; ++b)
#pragma unroll
            for (int m = 0; m < 4; ++m)
#pragma unroll
                for (int n = 0; n < 2; ++n) acc[a][b][m][n] = (f32x4){0.f, 0.f, 0.f, 0.f};
    bf16x8 At[4][2], B0[2][2], B1[2][2];
    const char* cA = (const char*)g.A + (size_t)cur.pm * tstepA; const char* cB = (const char*)g.Bt + (size_t)cur.pn * tstepB;
    PG8_STAGE(PG8_SB(0, 0), cB, voffB); PG8_STAGE(PG8_SB(0, 1), cB + hstepB, voffB); PG8_STAGE(PG8_SA(0, 0), cA, voffA); PG8_STAGE(PG8_SA(0, 1), cA + hstepA, voffA);
    if (wr == 1) PG8_BAR;
    PG8_WAIT_V(2); PG8_BAR;
    PG8_STAGE(PG8_SB(1, 0), cB + kstep, voffB); PG8_STAGE(PG8_SA(1, 0), cA + kstep, voffA); PG8_STAGE(PG8_SB(1, 1), cB + hstepB + kstep, voffB);
    PG8_WAIT_V(6); PG8_BAR;
    for (;;) {
        const bool has_next = S.next(ui + 1, nxt);
        const char* nA = has_next ? (const char*)g.A + (size_t)nxt.pm * tstepA : cA; const char* nB = has_next ? (const char*)g.Bt + (size_t)nxt.pn * tstepB : cB;
        for (int t = 0; t < nt; t += 2) {
            const bool last = (t == nt - 2);
            const char* a1 = cA + (size_t)(t + 1) * kstep;
            const char* a2 = last ? nA : cA + (size_t)(t + 2) * kstep; const char* b2 = last ? nB : cB + (size_t)(t + 2) * kstep;
            const char* a3 = a2 + kstep; const char* b3 = b2 + kstep;
            PG8_LDB(B0, 0, 0); PG8_LDB(B1, 0, 1); PG8_SCHED; PG8_LDA(At, 0, 0); PG8_STAGE(PG8_SA(1, 1), a1 + hstepA, voffA);
            PG8_WAIT_V(8); PG8_WAIT_L(0); PG8_BAR; PG8_MMA(0, 0, At, B0); PG8_MMA(0, 1, At, B1); PG8_BAR; PG8_SCHED;
            PG8_LDA(At, 0, 1); PG8_STAGE(PG8_SB(0, 0), b2, voffB); PG8_STAGE(PG8_SB(0, 1), b2 + hstepB, voffB); PG8_STAGE(PG8_SA(0, 0), a2, voffA);
            PG8_WAIT_V(8); PG8_WAIT_L(0); PG8_BAR; PG8_MMA(1, 0, At, B0); PG8_MMA(1, 1, At, B1); PG8_BAR; PG8_SCHED;
            PG8_LDB(B0, 1, 0); PG8_LDB(B1, 1, 1); PG8_SCHED; PG8_LDA(At, 1, 0); PG8_STAGE(PG8_SA(0, 1), a2 + hstepA, voffA);
            PG8_WAIT_V(8); PG8_WAIT_L(0); PG8_BAR; PG8_MMA(0, 0, At, B0); PG8_MMA(0, 1, At, B1); PG8_BAR; PG8_SCHED;
            PG8_LDA(At, 1, 1); PG8_STAGE(PG8_SB(1, 0), b3, voffB); PG8_STAGE(PG8_SB(1, 1), b3 + hstepB, voffB); PG8_STAGE(PG8_SA(1, 0), a3, voffA);
            PG8_WAIT_V(8); PG8_WAIT_L(0); PG8_BAR; PG8_MMA(1, 0, At, B0); PG8_MMA(1, 1, At, B1); PG8_BAR; PG8_SCHED;
        }
        if constexpr (ALIGN_EPI) { if (wr == 0) PG8_BAR; }
        E(acc, cur, wr, wc, fr, fq);
        if (!has_next) break;
#pragma unroll
        for (int a = 0; a < 2; ++a)
#pragma unroll
            for (int b = 0; b < 2; ++b)
#pragma unroll
                for (int m = 0; m < 4; ++m)
#pragma unroll
                    for (int n = 0; n < 2; ++n) acc[a][b][m][n] = (f32x4){0.f, 0.f, 0.f, 0.f};
        cur = nxt; cA = nA; cB = nB; ++ui;
        if constexpr (ALIGN_EPI) { if (wr == 1) PG8_BAR; }
    }
    PG8_WAIT_V(0);
    if constexpr (!ALIGN_EPI) { if (wr == 0) PG8_BAR; }
    PG8_BAR;
#undef PG8_SA
#undef PG8_SB
#undef PG8_STAGE
#undef PG8_LDA
#undef PG8_LDB
#undef PG8_MMA
#undef PG8_WAIT_V
#undef PG8_WAIT_L
#undef PG8_BAR
#undef PG8_SCHED
}

#define EPI_LOOP_ROWS for (int ai = 0; ai < 2; ++ai) for (int m = 0; m < 4; ++m)
struct EpiU {
    static constexpr bool PERM = true;
    bf16_t* U; const float* rs; bf16_t* HB;
    __device__ __forceinline__ void operator()(const f32x4 (&acc)[2][2][4][2], const Unit& u, int wr, int wc, int fr, int fq) const {
        const int row0 = u.pm * BM + wr * 64 + fr, col0 = u.pn * BM + wc * 32 + 8 * fq;
#pragma unroll
        for (int ai = 0; ai < 2; ++ai)
#pragma unroll
            for (int m = 0; m < 4; ++m) {
                const int row = row0 + ai * HALF + m * 16; const float s = rs[row]; bf16_t* rowp = U + (size_t)row * LDU + col0;
                const int r63 = m * 16 + fr;
#pragma unroll
                for (int bj = 0; bj < 2; ++bj) {
                    const f32x4 v0 = acc[ai][bj][m][0] * s, v1 = acc[ai][bj][m][1] * s;
                    u32x4 w; w.x = cvt_pk_bf16(v0[0], v0[1]); w.y = cvt_pk_bf16(v0[2], v0[3]); w.z = cvt_pk_bf16(v1[0], v1[1]); w.w = cvt_pk_bf16(v1[2], v1[3]);
                    *(u32x4*)(rowp + bj * HALF) = w;
                    const int c = col0 + bj * HALF;
                    if (c >= UC_QB && c < UC_QB + 768 && (r63 == 0 || r63 >= 62)) {
                        const int slot = r63 == 0 ? 0 : r63 - 61;
                        *(u32x4*)(HB + ((size_t)(row >> 6) * 3 + slot) * 768 + (c - UC_QB)) = w;
                    }
                }
            }
    }
};
__device__ __forceinline__ float rs_of(const float* rs, const float* ssp, int row) {
    if (!ssp) return rs[row];
    const f32x4* p = (const f32x4*)(ssp + (size_t)row * 16); const f32x4 a = p[0], b = p[1], c = p[2], d = p[3];
    return 1.f / sqrtf((((a[0] + a[1]) + (a[2] + a[3])) + ((b[0] + b[1]) + (b[2] + b[3])) + ((c[0] + c[1]) + (c[2] + c[3])) + ((d[0] + d[1]) + (d[2] + d[3]))) * (1.f / DM) + EPS);
}
struct EpiResN {
    static constexpr bool PERM = true;
    float* O; bf16_t* XB; float* ssp; const float* XP; const float* XS;
    __device__ __forceinline__ void operator()(const f32x4 (&acc)[2][2][4][2], const Unit& u, int wr, int wc, int fr, int fq) const {
        const int row0 = u.pm * BM + wr * 64 + fr, col0 = u.pn * BM + wc * 32 + 8 * fq, lane = fq * 16 + fr;
        const float* src = XP ? (u.pm < 128 ? XP : XS - (size_t)32768 * DM) : O;
#pragma unroll
        for (int ai = 0; ai < 2; ++ai) {
            f32x4 xv[4][2][2];
#pragma unroll
            for (int m = 0; m < 4; ++m)
#pragma unroll
                for (int bj = 0; bj < 2; ++bj) { const f32x4* p = (const f32x4*)(src + (size_t)(row0 + ai * HALF + m * 16) * DM + col0 + bj * HALF); xv[m][bj][0] = p[0]; xv[m][bj][1] = p[1]; }
#pragma unroll
            for (int m = 0; m < 4; ++m) {
                const int row = row0 + ai * HALF + m * 16; float ss = 0.f;
#pragma unroll
                for (int bj = 0; bj < 2; ++bj) {
                    f32x4* p = (f32x4*)(O + (size_t)row * DM + col0 + bj * HALF);
                    const f32x4 a = xv[m][bj][0] + acc[ai][bj][m][0], b = xv[m][bj][1] + acc[ai][bj][m][1];
                    p[0] = a; p[1] = b;
                    ss += ((a[0] * a[0] + a[1] * a[1]) + (a[2] * a[2] + a[3] * a[3])) + ((b[0] * b[0] + b[1] * b[1]) + (b[2] * b[2] + b[3] * b[3]));
                    u32x4 w; w.x = cvt_pk_bf16(a[0], a[1]); w.y = cvt_pk_bf16(a[2], a[3]); w.z = cvt_pk_bf16(b[0], b[1]); w.w = cvt_pk_bf16(b[2], b[3]);
                    *(u32x4*)(XB + (size_t)row * DM + col0 + bj * HALF) = w;
                }
                ss += shx(ss, 16, lane); ss += shx(ss, 32, lane);
                if (fq == 0) ssp[(size_t)row * 16 + u.pn * 4 + wc] = ss;
            }
        }
    }
};
struct EpiRes {
    static constexpr bool PERM = true;
    float* O;
    __device__ __forceinline__ void operator()(const f32x4 (&acc)[2][2][4][2], const Unit& u, int wr, int wc, int fr, int fq) const {
        const int row0 = u.pm * BM + wr * 64 + fr, col0 = u.pn * BM + wc * 32 + 8 * fq;
#pragma unroll
        for (int ai = 0; ai < 2; ++ai)
#pragma unroll
            for (int m = 0; m < 4; ++m) {
                float* rowp = O + (size_t)(row0 + ai * HALF + m * 16) * DM + col0;
#pragma unroll
                for (int bj = 0; bj < 2; ++bj) {
                    f32x4* p = (f32x4*)(rowp + bj * HALF);
                    const f32x4 a = p[0], b = p[1];
                    p[0] = a + acc[ai][bj][m][0]; p[1] = b + acc[ai][bj][m][1];
                }
            }
    }
};
struct EpiGU {
    static constexpr bool PERM = true;
    bf16_t* G; bf16_t* Up; const float* rs; const float* ssp;
    __device__ __forceinline__ void operator()(const f32x4 (&acc)[2][2][4][2], const Unit& u, int wr, int wc, int fr, int fq) const {
        const int row0 = u.pm * BM + wr * 64 + fr, col0 = u.pn * HALF + wc * 32 + 8 * fq;
#pragma unroll
        for (int ai = 0; ai < 2; ++ai)
#pragma unroll
            for (int m = 0; m < 4; ++m) {
                const int row = row0 + ai * HALF + m * 16; const float s = rs_of(rs, ssp, row);
#pragma unroll
                for (int bj = 0; bj < 2; ++bj) {
                    const f32x4 v0 = acc[ai][bj][m][0] * s, v1 = acc[ai][bj][m][1] * s;
                    u32x4 w; w.x = cvt_pk_bf16(v0[0], v0[1]); w.y = cvt_pk_bf16(v0[2], v0[3]); w.z = cvt_pk_bf16(v1[0], v1[1]); w.w = cvt_pk_bf16(v1[2], v1[3]);
                    *(u32x4*)((bj ? Up : G) + (size_t)row * DFF + col0) = w;
                }
            }
    }
};
struct EpiP {
    static constexpr bool PERM = true;
    bf16_t* P;
    __device__ __forceinline__ void operator()(const f32x4 (&acc)[2][2][4][2], const Unit& u, int wr, int wc, int fr, int fq) const {
        const int row0 = u.pm * BM + wr * 64 + fr, col0 = u.pn * BM + wc * 32 + 8 * fq;
#pragma unroll
        for (int ai = 0; ai < 2; ++ai)
#pragma unroll
            for (int m = 0; m < 4; ++m) {
                bf16_t* rowp = P + (size_t)(row0 + ai * HALF + m * 16) * DM + col0;
#pragma unroll
                for (int bj = 0; bj < 2; ++bj) {
                    const f32x4 v0 = acc[ai][bj][m][0], v1 = acc[ai][bj][m][1];
                    u32x4 w; w.x = cvt_pk_bf16(v0[0], v0[1]); w.y = cvt_pk_bf16(v0[2], v0[3]); w.z = cvt_pk_bf16(v1[0], v1[1]); w.w = cvt_pk_bf16(v1[2], v1[3]);
                    *(u32x4*)(rowp + bj * HALF) = w;
                }
            }
    }
};
struct EpiPle {
    static constexpr bool PERM = true;
    float* O; const bf16_t* P; const float* rs; const float* ssp;
    __device__ __forceinline__ void operator()(const f32x4 (&acc)[2][2][4][2], const Unit& u, int wr, int wc, int fr, int fq) const {
        const int row0 = u.pm * BM + wr * 64 + fr, col0 = u.pn * BM + wc * 32 + 8 * fq;
#pragma unroll
        for (int ai = 0; ai < 2; ++ai)
#pragma unroll
            for (int mh = 0; mh < 2; ++mh) {
                f32x4 xv[2][2][2]; u32x4 pv[2][2];
#pragma unroll
                for (int mm = 0; mm < 2; ++mm) {
                    const int row = row0 + ai * HALF + (2 * mh + mm) * 16;
#pragma unroll
                    for (int bj = 0; bj < 2; ++bj) { const f32x4* p = (const f32x4*)(O + (size_t)row * DM + col0 + bj * HALF); xv[mm][bj][0] = p[0]; xv[mm][bj][1] = p[1];
                        pv[mm][bj] = *(const u32x4*)(P + (size_t)row * DM + col0 + bj * HALF); }
                }
#pragma unroll
                for (int mm = 0; mm < 2; ++mm) {
                    const int m = 2 * mh + mm, row = row0 + ai * HALF + m * 16; const float s = rs_of(rs, ssp, row);
#pragma unroll
                    for (int bj = 0; bj < 2; ++bj) {
                        f32x4* p = (f32x4*)(O + (size_t)row * DM + col0 + bj * HALF);
                        const u32x4 pw = pv[mm][bj];
                        f32x4 a = xv[mm][bj][0], b = xv[mm][bj][1];
                        const f32x4 g0 = acc[ai][bj][m][0] * s, g1 = acc[ai][bj][m][1] * s;
                        a[0] += sigmoidf_(g0[0]) * bflo(pw.x); a[1] += sigmoidf_(g0[1]) * bfhi(pw.x); a[2] += sigmoidf_(g0[2]) * bflo(pw.y); a[3] += sigmoidf_(g0[3]) * bfhi(pw.y);
                        b[0] += sigmoidf_(g1[0]) * bflo(pw.z); b[1] += sigmoidf_(g1[1]) * bfhi(pw.z); b[2] += sigmoidf_(g1[2]) * bflo(pw.w); b[3] += sigmoidf_(g1[3]) * bfhi(pw.w);
                        p[0] = a; p[1] = b;
                    }
                }
            }
    }
};
}
struct Args { const float* in[32]; float* out; unsigned char* ws; };
typedef const __attribute__((address_space(4))) Args* KArgs;
__device__ __forceinline__ KArgs kargs() { KArgs p = (KArgs)__builtin_amdgcn_kernarg_segment_ptr(); asm volatile("" : "+s"(p)); return p; }
__device__ __forceinline__ int tidx(int wv) { unsigned z = 0u; asm volatile("" : "+s"(wv), "+s"(z)); int t = wv * 64 + (int)__builtin_amdgcn_mbcnt_hi(~0u, __builtin_amdgcn_mbcnt_lo(~0u, z)); asm volatile("" : "+v"(t)); return t; }
__device__ __forceinline__ int bidx() { int t = blockIdx.x; asm volatile("" : "+s"(t)); return t; }
__device__ __forceinline__ int gdim() { int t = gridDim.x; asm volatile("" : "+s"(t)); return t; }
enum { I_XP = 0, I_XS, I_PP, I_PS, I_N1, I_N2, I_N3, I_WIN, I_WOUT, I_CAW, I_CAB, I_LWR, I_LBR, I_LWI, I_LBI, I_LLAM, I_GCONV, I_GALOG, I_GDT, I_GNORM,
       I_RDEC, I_RNORM, I_QN, I_KN, I_RPB, I_WG, I_WU, I_FCW, I_FCB, I_WD, I_PPROJ, I_PGATE };
constexpr int LDS_BYTES = 147456;
#define GSYNC_CG() do { cg::this_grid().sync(); } while (0)
__device__ __forceinline__ void grid_bar(unsigned target) {
    __syncthreads();
    if (threadIdx.x == 0) {
        unsigned* ctr = (unsigned*)(kargs()->ws + WS_BAR);
        __builtin_amdgcn_fence(__ATOMIC_RELEASE, "agent");
        (void)__hip_atomic_fetch_add(ctr, 1u, __ATOMIC_RELAXED, __HIP_MEMORY_SCOPE_AGENT);
        while (__hip_atomic_load(ctr, __ATOMIC_RELAXED, __HIP_MEMORY_SCOPE_AGENT) < target) __builtin_amdgcn_s_sleep(2);
        __builtin_amdgcn_fence(__ATOMIC_ACQUIRE, "agent");
    }
    __syncthreads();
}
#define GSYNC() do { nbar += gridDim.x; grid_bar(nbar); } while (0)

__device__ __forceinline__ void tr_item(const float* __restrict__ W, int N, const float* __restrict__ gain, bf16_t* WT, int K, int k0, int src_n0, int dst_n0, float* scr, int lane) {
#pragma unroll 8
    for (int i = 0; i < 32; ++i) { const int kk = 2 * i + (lane >> 5); const float g = gain ? gain[k0 + kk] : 1.f;
        scr[kk * 33 + (lane & 31)] = W[(size_t)(k0 + kk) * N + src_n0 + (lane & 31)] * g; }
    LDSW();
    const int c = lane & 7;
#pragma unroll
    for (int j = 0; j < 4; ++j) { const int n = (lane >> 3) + 8 * j; const float* s = scr + (8 * c) * 33 + n;
        u32x4 o; o.x = pk2(s[0 * 33], s[1 * 33]); o.y = pk2(s[2 * 33], s[3 * 33]); o.z = pk2(s[4 * 33], s[5 * 33]); o.w = pk2(s[6 * 33], s[7 * 33]);
        *(u32x4*)(WT + (size_t)(dst_n0 + n) * K + k0 + 8 * c) = o; }
    LDSW();
}
__device__ __forceinline__ int win_src(int d) {
    if (d < 256) return 256 + d;
    if (d < 512) return 1280 + (d - 256);
    if (d < 768) return 2320 + (d - 512);
    if (d < 1024) return 2576 + (d - 768);
    if (d < 1280) return d - 1024;
    if (d < 2048) return 512 + (d - 1280);
    if (d < 2816) return 1552 + (d - 2048);
    return 2832 + (d - 2816);
}
__device__ __forceinline__ void phase_weights(int wv, int l, int which, int b0 = 0) {
    asm volatile("" : "+s"(l));
    unsigned char* lds = lds_dyn;
    KArgs a = kargs();
    const int tid_ = tidx(wv), bid_ = bidx(), gd_ = gdim();
    const int lane = tid_ & 63, wave = tid_ >> 6;
    float* scr = (float*)lds + 65536 / 4 + wave * (64 * 33);
    if (bid_ < b0) return;
    const int gw = (bid_ - b0) * 8 + wave, NGW = (gd_ - b0) * 8;
    unsigned char* ws = a->ws;
    constexpr int nWin = 16 * 104, nWout = 16 * 32, nWgu = 16 * 176, nWd = 44 * 32, nWpg = 16 * 32, nWpp = 4 * 32;
    if (which & 1) {
        for (int it = gw; it < nWin + nWout; it += NGW) {
            int r = it;
            if (r < nWin) { const int kb = r / 104, nb = r % 104; tr_item(a->in[I_WIN] + (size_t)l * DM * INC, INC, a->in[I_N1] + l * DM, (bf16_t*)(ws + WS_WIN), DM, kb * 64, win_src(nb * 32), nb * 32, scr, lane); continue; }
            r -= nWin;
            { const int kb = r / 32, nb = r % 32; tr_item(a->in[I_WOUT] + (size_t)l * DM * DM, DM, nullptr, (bf16_t*)(ws + WS_WOUT), DM, kb * 64, nb * 32, nb * 32, scr, lane); }
        }
        bf16_t* wl = (bf16_t*)(ws + WS_LRU);
        for (int i = (bid_ - b0) * 512 + tid_; i < 65536; i += (gd_ - b0) * 512) {
            const int k = i & 63, n = (i >> 6) & 63, h = (i >> 12) & 3, ty = (i >> 14) & 1, dir = i >> 15;
            const float* src = a->in[ty ? I_LWI : I_LWR] + (size_t)l * 32768 + (size_t)(dir * 4 + h) * 4096;
            wl[i] = (bf16_t)f2bf(src[k * 64 + n]);
        }
    }
    if (which & 2) {
        for (int it = gw; it < nWgu + nWd + nWpg + nWpp; it += NGW) {
            int r = it;
            if (r < nWgu) { const int kb = r / 176, nb = r % 176, d0 = nb * 32, pn = d0 >> 8, w = d0 & 255;
                tr_item(a->in[w < 128 ? I_WG : I_WU] + (size_t)l * DM * DFF, DFF, a->in[I_N2] + l * DM, (bf16_t*)(ws + WS_WGU), DM, kb * 64, pn * 128 + (w & 127), d0, scr, lane); continue; }
            r -= nWgu;
            if (r < nWd) { const int kb = r / 32, nb = r % 32; tr_item(a->in[I_WD] + (size_t)l * DFF * DM, DM, nullptr, (bf16_t*)(ws + WS_WD), DFF, kb * 64, nb * 32, nb * 32, scr, lane); continue; }
            r -= nWd;
            if (r < nWpg) { const int kb = r / 32, nb = r % 32; tr_item(a->in[I_PGATE] + (size_t)l * DM * DM, DM, a->in[I_N3] + l * DM, (bf16_t*)(ws + WS_WPG), DM, kb * 64, nb * 32, nb * 32, scr, lane); continue; }
            r -= nWpg;
            { const int kb = r / 32, nb = r % 32; tr_item(a->in[I_PPROJ] + (size_t)l * PLED * DM, DM, nullptr, (bf16_t*)(ws + WS_WPP), PLED, kb * 64, nb * 32, nb * 32, scr, lane); }
        }
    }
}

__device__ __forceinline__ void phase_norm(int wv, int l, int mode) {
    asm volatile("" : "+s"(l));
    unsigned char* lds = lds_dyn;
    KArgs a = kargs();
    const int tid_ = tidx(wv), bid_ = bidx(), gd_ = gdim();
    const int lane = tid_ & 63, wave = tid_ >> 6;
    const int gw = bid_ * 8 + wave, NGW = gd_ * 8;
    float* Wba = (float*)lds;
    if (mode & 2) {
        const float* win = a->in[I_WIN] + (size_t)l * DM * INC; const float* g1 = a->in[I_N1] + l * DM;
        for (int i = tid_; i < 16384; i += 512) { const int j = i & 15, k = i >> 4; Wba[j * 1024 + k] = win[(size_t)k * INC + 1536 + j] * g1[k]; }
        __syncthreads();
    }
    bf16_t* xb = (bf16_t*)(a->ws + WS_XB); float* rs = (float*)(a->ws + WS_RS); float* ba = (float*)(a->ws + WS_BA);
    for (int m = gw; m < M_TOK; m += NGW) {
        const float* xrow = (mode & 1) ? (m < 32768 ? a->in[I_XP] + (size_t)m * DM : a->in[I_XS] + (size_t)(m - 32768) * DM) : a->out + (size_t)m * DM;
        const f32x4* xr = (const f32x4*)xrow + lane;
        f32x4 v[4]; float s = 0.f;
#pragma unroll
        for (int j = 0; j < 4; ++j) { v[j] = xr[64 * j]; s += (v[j].x * v[j].x + v[j].y * v[j].y) + (v[j].z * v[j].z + v[j].w * v[j].w); }
        const float r = 1.f / sqrtf(wave_sum(s, lane) * (1.f / DM) + EPS);
        u32x2* o8 = (u32x2*)(xb + (size_t)m * DM) + lane;
#pragma unroll
        for (int j = 0; j < 4; ++j) { u32x2 w; w.x = pk2(v[j].x, v[j].y); w.y = pk2(v[j].z, v[j].w); o8[64 * j] = w; }
        if (lane == 0) rs[m] = r;
        if (mode & 2) {
            float mine = 0.f;
#pragma unroll 1
            for (int o = 0; o < 16; ++o) {
                float d = 0.f;
#pragma unroll
                for (int j = 0; j < 4; ++j) { const f32x4 w = *(const f32x4*)(Wba + o * 1024 + 256 * j + 4 * lane); d += (v[j].x * w.x + v[j].y * w.y) + (v[j].z * w.z + v[j].w * w.w); }
                d = wave_sum(d, lane);
                if (lane == o) mine = d;
            }
            if (lane < 16) ba[(size_t)m * 16 + lane] = mine * r;
        }
    }
}

__device__ __forceinline__ void phase_ffn_elem(int wv, int l, int row0) {
    asm volatile("" : "+s"(l));
    KArgs a = kargs();
    const int tid_ = tidx(wv), bid_ = bidx(), gd_ = gdim();
    const bf16_t* G = (const bf16_t*)(a->ws + WS_G); bf16_t* Up = (bf16_t*)(a->ws + WS_UP);
    const float* cw = a->in[I_FCW] + (size_t)l * 3 * DFF; const float* cb = a->in[I_FCB] + (size_t)l * DFF;
    constexpr int C8 = DFF / 8, RSEG = 32, NSEG = MH / RSEG;
    for (int idx = bid_ * 512 + tid_; idx < NSEG * C8; idx += gd_ * 512) {
        const int c = (idx % C8) * 8, r0 = (idx / C8) * RSEG;
        float w0[8], w1[8], w2[8], bb[8];
#pragma unroll
        for (int h4 = 0; h4 < 2; ++h4) { const f32x4 x0 = *(const f32x4*)(cw + c + 4 * h4), x1 = *(const f32x4*)(cw + DFF + c + 4 * h4), x2 = *(const f32x4*)(cw + 2 * DFF + c + 4 * h4), x3 = *(const f32x4*)(cb + c + 4 * h4);
#pragma unroll
            for (int e = 0; e < 4; ++e) { w0[4 * h4 + e] = x0[e]; w1[4 * h4 + e] = x1[e]; w2[4 * h4 + e] = x2[e]; bb[4 * h4 + e] = x3[e]; } }
        const u32x4 z = {0u, 0u, 0u, 0u};
        const int t0 = row0 + r0;
        u32x4 gm = (t0 == seq_start_tok(t0)) ? z : *(const u32x4*)(G + (size_t)(r0 - 1) * DFF + c);
        u32x4 g0 = *(const u32x4*)(G + (size_t)r0 * DFF + c);
#pragma unroll 4
        for (int rr = 0; rr < RSEG; ++rr) {
            const int rl = r0 + rr, t = row0 + rl;
            const u32x4 gp = (t + 1 == seq_end_tok(t)) ? z : *(const u32x4*)(G + (size_t)(rl + 1) * DFF + c);
            const u32x4 up = *(const u32x4*)(Up + (size_t)rl * DFF + c);
            float o[8];
#pragma unroll
            for (int j = 0; j < 4; ++j) {
                const float ga = w0[2 * j] * bflo(gm[j]) + w1[2 * j] * bflo(g0[j]) + w2[2 * j] * bflo(gp[j]) + bb[2 * j];
                const float gb = w0[2 * j + 1] * bfhi(gm[j]) + w1[2 * j + 1] * bfhi(g0[j]) + w2[2 * j + 1] * bfhi(gp[j]) + bb[2 * j + 1];
                o[2 * j] = gelu_tanh(ga) * bflo(up[j]); o[2 * j + 1] = gelu_tanh(gb) * bfhi(up[j]);
            }
            u32x4 w; w.x = pk2(o[0], o[1]); w.y = pk2(o[2], o[3]); w.z = pk2(o[4], o[5]); w.w = pk2(o[6], o[7]);
            *(u32x4*)(Up + (size_t)rl * DFF + c) = w;
            gm = g0; g0 = gp;
        }
    }
}
__device__ __forceinline__ void phase_pconv(int wv, int l) {
    asm volatile("" : "+s"(l));
    KArgs a = kargs();
    const int tid_ = tidx(wv), bid_ = bidx(), gd_ = gdim();
    bf16_t* pb = (bf16_t*)(a->ws + WS_PB);
    const float* pp = a->in[I_PP] + (size_t)l * 32768 * PLED; const float* ps = a->in[I_PS] + (size_t)l * 16384 * PLED;
    for (int idx = bid_ * 512 + tid_; idx < M_TOK * PLED / 4; idx += gd_ * 512) {
        const size_t e = (size_t)idx * 4;
        const f32x4 v = e < (size_t)32768 * PLED ? *(const f32x4*)(pp + e) : *(const f32x4*)(ps + (e - (size_t)32768 * PLED));
        u32x2 w; w.x = pk2(v.x, v.y); w.y = pk2(v.z, v.w);
        *(u32x2*)(pb + e) = w;
    }
}
__device__ __forceinline__ int chunk_seq_c0(int gc) { return gc < 512 ? (gc & ~127) : 512; }
__device__ __forceinline__ int chunk_seq_n(int gc) { return gc < 512 ? 128 : 256; }
__device__ __forceinline__ void unpack8(const u32x4 w, float* f) {
    f[0] = bflo(w.x); f[1] = bfhi(w.x); f[2] = bflo(w.y); f[3] = bfhi(w.y); f[4] = bflo(w.z); f[5] = bfhi(w.z); f[6] = bflo(w.w); f[7] = bfhi(w.w);
}
__device__ __forceinline__ u32x4 pack8(const float* f) { u32x4 w; w.x = pk2(f[0], f[1]); w.y = pk2(f[2], f[3]); w.z = pk2(f[4], f[5]); w.w = pk2(f[6], f[7]); return w; }

#define RAW_BAR() do { asm volatile("s_waitcnt lgkmcnt(0)" ::: "memory"); __builtin_amdgcn_s_barrier(); asm volatile("" ::: "memory"); } while (0)

__device__ __forceinline__ void mixD_job(KArgs a, int l, int gc, int h, int tid, bool dry) {
    asm volatile("" : "+s"(l));
    unsigned char* lds = lds_dyn;
    asm volatile("" : "+v"(tid));
    bf16_t* U = (bf16_t*)(a->ws + WS_U);
    bf16_t* Kn = (bf16_t*)lds;
    bf16_t* Vt = (bf16_t*)(lds + 65536);
    bf16_t* Qs = (bf16_t*)(lds + 65536 + 66560);
    float* Rp = (float*)(lds + 65536 + 66560 + 9216);
    const int lane = tid & 63, wave = tid >> 6;
    const int c0s = chunk_seq_c0(gc), rows = chunk_seq_n(gc), r = gc - c0s;
    int r0 = r - 4; r0 = r0 < 0 ? 0 : (r0 > rows - 8 ? rows - 8 : r0);
    {
        const int ch = tid & 7, kq = tid >> 3;
        const float* gk = a->in[I_KN] + l * 64 + ch * 8; const float* gq = a->in[I_QN] + l * 64 + ch * 8;
        u32x4 kw[8], vw[8];
#pragma unroll
        for (int it = 0; it < 8; ++it) { const int key = it * 64 + kq; const size_t tok = (size_t)(c0s + r0 + (key >> 6)) * 64 + (key & 63);
            kw[it] = *(const u32x4*)(U + tok * LDU + UC_KD + h * 64 + ch * 8); vw[it] = *(const u32x4*)(U + tok * LDU + UC_VD + h * 64 + ch * 8); }
        const u32x4 qw = *(const u32x4*)(U + ((size_t)gc * 64 + kq) * LDU + UC_QD + h * 64 + ch * 8);
        float gkf[8], gqf[8];
#pragma unroll
        for (int j = 0; j < 8; ++j) { gkf[j] = gk[j]; gqf[j] = gq[j]; }
        const float* rpb = a->in[I_RPB] + (size_t)(l * 4 + h) * 465;
        if (tid < 465) Rp[tid] = rpb[tid];
#pragma unroll
        for (int it = 0; it < 8; ++it) { const int key = it * 64 + kq;
            float f[8]; unpack8(kw[it], f); float ss = 0.f;
#pragma unroll
            for (int j = 0; j < 8; ++j) ss += f[j] * f[j];
            ss += shx(ss, 1, tid); ss += shx(ss, 2, tid); ss += shx(ss, 4, tid);
            const float inv = 1.f / sqrtf(ss * (1.f / 64.f) + EPS);
#pragma unroll
            for (int j = 0; j < 8; ++j) f[j] = f[j] * inv * gkf[j];
            *(u32x4*)(Kn + key * 64 + ((ch ^ (key & 7)) << 3)) = pack8(f);
            const unsigned ww[4] = {vw[it].x, vw[it].y, vw[it].z, vw[it].w};
#pragma unroll
            for (int j = 0; j < 4; ++j) { Vt[(ch * 8 + 2 * j) * 520 + key] = (bf16_t)(ww[j] & 0xffffu); Vt[(ch * 8 + 2 * j + 1) * 520 + key] = (bf16_t)(ww[j] >> 16); } }
        {   float f[8]; unpack8(qw, f); float s2 = 0.f;
#pragma unroll
            for (int j = 0; j < 8; ++j) s2 += f[j] * f[j];
            s2 += shx(s2, 1, tid); s2 += shx(s2, 2, tid); s2 += shx(s2, 4, tid);
            const float qi = 0.125f / sqrtf(s2 * (1.f / 64.f) + EPS);
#pragma unroll
            for (int j = 0; j < 8; ++j) f[j] = f[j] * qi * gqf[j];
            *(u32x4*)(Qs + kq * 72 + ch * 8) = pack8(f); }
    }
    RAW_BAR();
    const int g = wave & 3, c = lane & 15, q = lane >> 4;
    const int cstart = g == 0 ? 0 : (g == 1 ? 8 : (g == 2 ? 24 : 32));
    f32x4 sc[16];
    if (wave < 4) {
        const bf16x8 qa0 = *(const bf16x8*)(Qs + (16 * g + c) * 72 + 8 * q), qa1 = *(const bf16x8*)(Qs + (16 * g + c) * 72 + 32 + 8 * q);
#pragma unroll
        for (int tt = 0; tt < 16; ++tt) {
            const int key = (tt >> 1) * 64 + cstart + (tt & 1) * 16 + c;
            const bf16x8 b0 = *(const bf16x8*)(Kn + key * 64 + ((q ^ (key & 7)) << 3)), b1 = *(const bf16x8*)(Kn + key * 64 + (((4 + q) ^ (key & 7)) << 3));
            f32x4 z = {0.f, 0.f, 0.f, 0.f};
            z = mfma16(qa0, b0, z); sc[tt] = mfma16(qa1, b1, z);
        }
    }
    RAW_BAR();
    if (wave < 4) {
        bf16_t* Pst = Kn + wave * (16 * 264);
        float mx[4] = {-1e30f, -1e30f, -1e30f, -1e30f};
#pragma unroll
        for (int tt = 0; tt < 16; ++tt) {
            const int kr = tt >> 1, kc = cstart + (tt & 1) * 16 + c; const int dr = r0 + kr - r + 7;
#pragma unroll
            for (int j = 0; j < 4; ++j) {
                const int qc = 16 * g + 4 * q + j; int c0 = qc - 8; c0 = c0 < 0 ? 0 : (c0 > 48 ? 48 : c0);
                const bool ok = (kc >= c0) && (kc < c0 + 16);
                const float s = ok ? sc[tt][j] + Rp[dr * 31 + (kc - qc + 15)] : -1e30f;
                sc[tt][j] = s; mx[j] = fmaxf(mx[j], s);
            }
        }
        float sum[4];
#pragma unroll
        for (int j = 0; j < 4; ++j) { float m = mx[j]; m = fmaxf(m, shx(m, 1, tid)); m = fmaxf(m, shx(m, 2, tid)); m = fmaxf(m, shx(m, 4, tid)); m = fmaxf(m, shx(m, 8, tid)); mx[j] = m; sum[j] = 0.f; }
#pragma unroll
        for (int tt = 0; tt < 16; ++tt)
#pragma unroll
            for (int j = 0; j < 4; ++j) { const float p = sc[tt][j] > -1e29f ? __expf(sc[tt][j] - mx[j]) : 0.f; sum[j] += p; Pst[(4 * q + j) * 264 + tt * 16 + c] = (bf16_t)f2bf(p); }
#pragma unroll
        for (int j = 0; j < 4; ++j) { float s = sum[j]; s += shx(s, 1, tid); s += shx(s, 2, tid); s += shx(s, 4, tid); s += shx(s, 8, tid); sum[j] = 1.f / s; }
        LDSW();
        f32x4 o[4];
#pragma unroll
        for (int dt = 0; dt < 4; ++dt) o[dt] = (f32x4){0.f, 0.f, 0.f, 0.f};
#pragma unroll
        for (int kb = 0; kb < 8; ++kb) {
            const bf16x8 pa = *(const bf16x8*)(Pst + c * 264 + kb * 32 + 8 * q);
#pragma unroll
            for (int dt = 0; dt < 4; ++dt) { const bf16x8 vb = *(const bf16x8*)(Vt + (16 * dt + c) * 520 + kb * 64 + cstart + 8 * q); o[dt] = mfma16(pa, vb, o[dt]); }
        }
#pragma unroll
        for (int dt = 0; dt < 4; ++dt)
#pragma unroll
            for (int j = 0; j < 4; ++j) if (!dry) U[((size_t)gc * 64 + 16 * g + 4 * q + j) * LDU + UC_QD + h * 64 + 16 * dt + c] = (bf16_t)f2bf(o[dt][j] * sum[j]);
    }
    RAW_BAR();
}
__device__ __forceinline__ void mixC_local(KArgs a, int l, int gc, int h, int tid, bool dry) {
    asm volatile("" : "+s"(l));
    unsigned char* lds = lds_dyn;
    asm volatile("" : "+v"(tid));
    bf16_t* U = (bf16_t*)(a->ws + WS_U);
    bf16_t* Qh = (bf16_t*)lds; bf16_t* Kh = Qh + 64 * 72; bf16_t* Vt = Kh + 64 * 72; bf16_t* KfT = Vt + 64 * 72; bf16_t* KbT = KfT + 64 * 72; bf16_t* Ph = KbT + 64 * 72;
    const int lane = tid & 63, wave = tid >> 6;
    const int c0s = chunk_seq_c0(gc);
    const float lgf = log1p_small(-__builtin_amdgcn_exp2f(-a->in[I_RDEC][l * 8 + h])), lgb = log1p_small(-__builtin_amdgcn_exp2f(-a->in[I_RDEC][l * 8 + 4 + h]));
    const size_t t0 = (size_t)gc * 64;
    const int row = tid >> 3, ch = tid & 7;
    bf16_t* urow8 = U + (t0 + row) * LDU + h * 64 + ch * 8;
    {
        const u32x4 qw = *(const u32x4*)(urow8 + UC_QC), kw = *(const u32x4*)(urow8 + UC_KC), vw = *(const u32x4*)(urow8 + UC_VC);
        *(u32x4*)(Qh + row * 72 + ch * 8) = qw; *(u32x4*)(Kh + row * 72 + ch * 8) = kw;
        const unsigned ww[4] = {vw.x, vw.y, vw.z, vw.w};
#pragma unroll
        for (int j = 0; j < 4; ++j) { Vt[(ch * 8 + 2 * j) * 72 + row] = (bf16_t)(ww[j] & 0xffffu); Vt[(ch * 8 + 2 * j + 1) * 72 + row] = (bf16_t)(ww[j] >> 16); }
    }
    RAW_BAR();
    {
        const int p = tid & 31;
        const float inv = powf(10000.f, -(float)p * (1.f / 32.f));
#pragma unroll 1
        for (int i = tid >> 5; i < 64; i += 16) {
            const float pos = (float)((gc - c0s) * 64 + i);
            float sn, cs; sincosf(pos * inv, &sn, &cs);
            const float q1 = bf2f(Qh[i * 72 + p]), q2 = bf2f(Qh[i * 72 + p + 32]), k1 = bf2f(Kh[i * 72 + p]) * 0.125f, k2 = bf2f(Kh[i * 72 + p + 32]) * 0.125f;
            const float qa = q1 * cs - q2 * sn, qb = q1 * sn + q2 * cs, ka = k1 * cs - k2 * sn, kb = k1 * sn + k2 * cs;
            Qh[i * 72 + p] = (bf16_t)f2bf(qa); Qh[i * 72 + p + 32] = (bf16_t)f2bf(qb);
            Kh[i * 72 + p] = (bf16_t)f2bf(ka); Kh[i * 72 + p + 32] = (bf16_t)f2bf(kb);
            const float df = __expf((float)(63 - i) * lgf), db = __expf((float)i * lgb);
            KfT[p * 72 + i] = (bf16_t)f2bf(ka * df); KfT[(p + 32) * 72 + i] = (bf16_t)f2bf(kb * df);
            KbT[p * 72 + i] = (bf16_t)f2bf(ka * db); KbT[(p + 32) * 72 + i] = (bf16_t)f2bf(kb * db);
        }
    }
    RAW_BAR();
    if (!dry) *(u32x4*)(urow8 + UC_QC) = *(const u32x4*)(Qh + row * 72 + ch * 8);
    const int c = lane & 15, q = lane >> 4;
    bf16_t* KV = (bf16_t*)(a->ws + WS_KV);
#pragma unroll
    for (int s = 0; s < 2; ++s) {
        const int tile = 2 * wave + s, rt = tile >> 2, ct = tile & 3;
        {
            f32x4 z = {0.f, 0.f, 0.f, 0.f};
#pragma unroll
            for (int kb = 0; kb < 2; ++kb) z = mfma16(*(const bf16x8*)(Qh + (16 * rt + c) * 72 + kb * 32 + 8 * q), *(const bf16x8*)(Kh + (16 * ct + c) * 72 + kb * 32 + 8 * q), z);
#pragma unroll
            for (int j = 0; j < 4; ++j) { const int i = 16 * rt + 4 * q + j, jj = 16 * ct + c;
                const float dm = jj < i ? __expf((float)(i - jj) * lgf) : (jj > i ? __expf((float)(jj - i) * lgb) : 2.f);
                Ph[i * 72 + jj] = (bf16_t)f2bf(z[j] * dm); }
        }
#pragma unroll
        for (int dir = 0; dir < 2; ++dir) {
            const bf16_t* KT = dir ? KbT : KfT;
            f32x4 z = {0.f, 0.f, 0.f, 0.f};
#pragma unroll
            for (int kb = 0; kb < 2; ++kb) z = mfma16(*(const bf16x8*)(KT + (16 * rt + c) * 72 + kb * 32 + 8 * q), *(const bf16x8*)(Vt + (16 * ct + c) * 72 + kb * 32 + 8 * q), z);
            u32x2 w; w.x = pk2(z[0], z[1]); w.y = pk2(z[2], z[3]);
            if (!dry) *(u32x2*)(KV + ((size_t)(gc * 4 + h) * 2 + dir) * 4096 + (16 * ct + c) * 64 + 16 * rt + 4 * q) = w;
        }
    }
    RAW_BAR();
#pragma unroll
    for (int s = 0; s < 2; ++s) {
        const int tile = 2 * wave + s, rt = tile >> 2, ct = tile & 3;
        f32x4 z = {0.f, 0.f, 0.f, 0.f};
#pragma unroll
        for (int kb = 0; kb < 2; ++kb) z = mfma16(*(const bf16x8*)(Ph + (16 * rt + c) * 72 + kb * 32 + 8 * q), *(const bf16x8*)(Vt + (16 * ct + c) * 72 + kb * 32 + 8 * q), z);
#pragma unroll
        for (int j = 0; j < 4; ++j) if (!dry) U[(t0 + 16 * rt + 4 * q + j) * LDU + UC_VC + h * 64 + 16 * ct + c] = (bf16_t)f2bf(z[j]);
    }
    RAW_BAR();
}
__device__ __forceinline__ void mixC_scan(KArgs a, int l, int job, int tid, bool dry) {
    asm volatile("" : "+s"(l));
    asm volatile("" : "+v"(tid));
    const int quarter = job & 3, dir = (job >> 2) & 1, h = (job >> 3) & 3, s = job >> 5;
    const int c0 = s < 4 ? 128 * s : 512, n = s < 4 ? 128 : 256;
    const float lg = log1p_small(-__builtin_amdgcn_exp2f(-a->in[I_RDEC][l * 8 + dir * 4 + h]));
    const float D = __expf(64.f * lg);
    unsigned* KV = (unsigned*)(a->ws + WS_KV) + quarter * 512 + tid;
    float s0 = 0.f, s1 = 0.f;
    for (int nb = 0; nb < n; nb += 16) {
        unsigned w[16];
#pragma unroll
        for (int j = 0; j < 16; ++j) { const int gc = dir ? c0 + n - 1 - (nb + j) : c0 + nb + j; w[j] = KV[((size_t)(gc * 4 + h) * 2 + dir) * 2048]; }
#pragma unroll
        for (int j = 0; j < 16; ++j) { const int gc = dir ? c0 + n - 1 - (nb + j) : c0 + nb + j;
            if (!dry) KV[((size_t)(gc * 4 + h) * 2 + dir) * 2048] = pk2(s0, s1);
            s0 = s0 * D + bflo(w[j]); s1 = s1 * D + bfhi(w[j]); }
    }
}
__device__ __forceinline__ void mixC_final(KArgs a, int l, int gc, int h, int tid, bool dry) {
    asm volatile("" : "+s"(l));
    unsigned char* lds = lds_dyn;
    asm volatile("" : "+v"(tid));
    bf16_t* U = (bf16_t*)(a->ws + WS_U);
    bf16_t* Qf = (bf16_t*)lds; bf16_t* Qb = Qf + 64 * 72; float* Of = (float*)(lds + 2 * 64 * 72 * 2);
    const int lane = tid & 63, wave = tid >> 6;
    const float lgf = log1p_small(-__builtin_amdgcn_exp2f(-a->in[I_RDEC][l * 8 + h])), lgb = log1p_small(-__builtin_amdgcn_exp2f(-a->in[I_RDEC][l * 8 + 4 + h]));
    const size_t t0 = (size_t)gc * 64;
    const int row = tid >> 3, e0 = (tid & 7) * 8;
    bf16_t* urow8 = U + (t0 + row) * LDU + h * 64 + e0;
    const u32x4 qw = *(const u32x4*)(urow8 + UC_QC), iw = *(const u32x4*)(urow8 + UC_VC), gw = *(const u32x4*)(urow8 + UC_GC);
    const int c = lane & 15, q = lane >> 4;
    const bf16_t* KV = (const bf16_t*)(a->ws + WS_KV) + (size_t)(gc * 4 + h) * 2 * 4096;
    bf16x8 kvf[2][2], kvb[2][2];
#pragma unroll
    for (int s = 0; s < 2; ++s) { const int ct = (2 * wave + s) & 3;
#pragma unroll
        for (int kb = 0; kb < 2; ++kb) { kvf[s][kb] = *(const bf16x8*)(KV + (16 * ct + c) * 64 + kb * 32 + 8 * q); kvb[s][kb] = *(const bf16x8*)(KV + 4096 + (16 * ct + c) * 64 + kb * 32 + 8 * q); } }
    {
        float f[8], o[8]; unpack8(qw, f);
        const float ef = __expf((float)(row + 1) * lgf), eb = __expf((float)(64 - row) * lgb);
#pragma unroll
        for (int j = 0; j < 8; ++j) o[j] = f[j] * ef;
        *(u32x4*)(Qf + row * 72 + e0) = pack8(o);
#pragma unroll
        for (int j = 0; j < 8; ++j) o[j] = f[j] * eb;
        *(u32x4*)(Qb + row * 72 + e0) = pack8(o);
        unpack8(iw, f);
#pragma unroll
        for (int j = 0; j < 8; ++j) Of[row * 65 + e0 + j] = f[j];
    }
    RAW_BAR();
#pragma unroll
    for (int s = 0; s < 2; ++s) {
        const int tile = 2 * wave + s, rt = tile >> 2, ct = tile & 3;
        f32x4 z = {0.f, 0.f, 0.f, 0.f};
#pragma unroll
        for (int kb = 0; kb < 2; ++kb) {
            z = mfma16(*(const bf16x8*)(Qf + (16 * rt + c) * 72 + kb * 32 + 8 * q), kvf[s][kb], z);
            z = mfma16(*(const bf16x8*)(Qb + (16 * rt + c) * 72 + kb * 32 + 8 * q), kvb[s][kb], z);
        }
#pragma unroll
        for (int j = 0; j < 4; ++j) Of[(16 * rt + 4 * q + j) * 65 + 16 * ct + c] += z[j];
    }
    RAW_BAR();
    {
        const float* gn = a->in[I_RNORM] + l * 64;
        float v[8], s1 = 0.f;
#pragma unroll
        for (int j = 0; j < 8; ++j) { v[j] = Of[row * 65 + e0 + j]; s1 += v[j]; }
        s1 += shx(s1, 1, tid); s1 += shx(s1, 2, tid); s1 += shx(s1, 4, tid);
        const float mu = s1 * (1.f / 64.f); float s2 = 0.f;
#pragma unroll
        for (int j = 0; j < 8; ++j) { v[j] -= mu; s2 += v[j] * v[j]; }
        s2 += shx(s2, 1, tid); s2 += shx(s2, 2, tid); s2 += shx(s2, 4, tid);
        const float rstd = 1.f / sqrtf(s2 * (1.f / 64.f) + EPS);
        float g[8]; unpack8(gw, g);
#pragma unroll
        for (int j = 0; j < 8; ++j) v[j] = v[j] * rstd * gn[e0 + j] * siluf_(g[j]);
        if (!dry) *(u32x4*)(urow8 + UC_GC) = pack8(v);
    }
    RAW_BAR();
}

__device__ __forceinline__ void mixA_job(KArgs a, int l, int gc, int h, int pass, int tid, bool dry) {
    asm volatile("" : "+s"(l));
    unsigned char* lds = lds_dyn;
    asm volatile("" : "+v"(tid));
    bf16_t* U = (bf16_t*)(a->ws + WS_U);
    float* Xc = (float*)lds;
    bf16_t* Xh = (bf16_t*)(lds + 16640);
    float* Aa = (float*)(lds + 16640 + 9216);
    float* Bb = Aa + 2 * 64 * 65;
    bf16_t* Xr = (bf16_t*)(lds + 92416);
    float* Gp = (float*)(lds + 92416 + 9648);
    const int lane = tid & 63, wave = tid >> 6;
    const int t0 = gc * 64, ts = seq_start_tok(t0), te = seq_end_tok(t0);
    const int row = tid >> 3, ch8 = (tid & 7) * 8;
    u32x4 yaw = {0u, 0u, 0u, 0u}; float carry_in = 0.f;
    {
        const u32x4 z4 = {0u, 0u, 0u, 0u};
        { const int t = t0 - 2 + row; *(u32x4*)(Xr + row * 72 + ch8) = (t >= ts && t < te) ? *(const u32x4*)(U + (size_t)t * LDU + UC_XA + h * 64 + ch8) : z4; }
        if (tid < 24) { const int rr = 64 + row, t = t0 - 2 + rr; *(u32x4*)(Xr + rr * 72 + ch8) = (t >= ts && t < te) ? *(const u32x4*)(U + (size_t)t * LDU + UC_XA + h * 64 + ch8) : z4; }
        if (pass == 2) yaw = *(const u32x4*)(U + (size_t)(t0 + row) * LDU + UC_YA + h * 64 + ch8);
        if (pass == 2) carry_in = ((const float*)(a->ws + WS_ASUM))[((size_t)(gc * 2 + (tid >> 8)) * 2 + 1) * 256 + h * 64 + ((tid >> 2) & 63)];
        if (tid < 128) { const int dir = tid >> 6, n = tid & 63, o = l * 512 + dir * 256 + h * 64 + n;
            Gp[tid] = a->in[I_LBR][o]; Gp[128 + tid] = a->in[I_LBI][o]; Gp[256 + tid] = softplusf_(-a->in[I_LLAM][o]); }
    }
    bf16x8 wl[4][2][2];
    { const bf16_t* WLp = (const bf16_t*)(a->ws + WS_LRU); const int dirw = (tid >> 6) >> 2, cc = tid & 15, qq = (tid & 63) >> 4;
#pragma unroll
      for (int ct = 0; ct < 4; ++ct)
#pragma unroll
        for (int ty = 0; ty < 2; ++ty)
#pragma unroll
          for (int kb = 0; kb < 2; ++kb) wl[ct][ty][kb] = *(const bf16x8*)(WLp + (size_t)((dirw * 2 + ty) * 4 + h) * 4096 + (16 * ct + cc) * 64 + kb * 32 + 8 * qq); }
    const float* cw = a->in[I_CAW] + l * 1024 + h * 64 + (tid & 63); const float cbv = a->in[I_CAB][l * 256 + h * 64 + (tid & 63)];
    const float cw0 = cw[0], cw1 = cw[256], cw2 = cw[512], cw3 = cw[768];
    RAW_BAR();
    {
        const int n = tid & 63;
#pragma unroll
        for (int k = 0; k < 8; ++k) { const int i = (tid >> 6) + 8 * k;
            const float acc = cbv + cw0 * bf2f(Xr[i * 72 + n]) + cw1 * bf2f(Xr[(i + 1) * 72 + n]) + cw2 * bf2f(Xr[(i + 2) * 72 + n]) + cw3 * bf2f(Xr[(i + 3) * 72 + n]);
            Xc[i * 65 + n] = acc; Xh[i * 72 + n] = (bf16_t)f2bf(acc); }
    }
    RAW_BAR();
    const int c = lane & 15, q = lane >> 4;
#pragma unroll
    for (int s = 0; s < 4; ++s) {
        const int pr = 4 * wave + s, dir = pr >> 4, tile = pr & 15, rt = tile >> 2, ct = s;
        f32x4 zr = {0.f, 0.f, 0.f, 0.f}, zi = {0.f, 0.f, 0.f, 0.f};
#pragma unroll
        for (int kb = 0; kb < 2; ++kb) {
            const bf16x8 xa = *(const bf16x8*)(Xh + (16 * rt + c) * 72 + kb * 32 + 8 * q);
            zr = mfma16(xa, wl[s][0][kb], zr);
            zi = mfma16(xa, wl[s][1][kb], zi);
        }
        const int n = 16 * ct + c;
        const float br = Gp[dir * 64 + n], bi = Gp[128 + dir * 64 + n], sp = Gp[256 + dir * 64 + n];
#pragma unroll
        for (int j = 0; j < 4; ++j) { const int i = 16 * rt + 4 * q + j;
            const float r = sigmoidf_(zr[j] + br), ig = sigmoidf_(zi[j] + bi);
            const float la = -8.f * r * sp;
            Aa[(dir * 64 + i) * 65 + n] = __expf(la);
            Bb[(dir * 64 + i) * 65 + n] = sqrtf(neg_expm1(2.f * la)) * (ig * Xc[i * 65 + n]); }
    }
    RAW_BAR();
    float* AS = (float*)(a->ws + WS_ASUM);
    {
        const int chain = tid >> 2, seg = tid & 3, dir = chain >> 6, n = chain & 63, chn = h * 64 + n;
        float* sum = AS + ((size_t)(gc * 2 + dir) * 2) * 256 + chn;
        float av[16], bv[16];
#pragma unroll
        for (int k = 0; k < 16; ++k) { const int ii = seg * 16 + k, i = dir ? 63 - ii : ii; av[k] = Aa[(dir * 64 + i) * 65 + n]; bv[k] = Bb[(dir * 64 + i) * 65 + n]; }
        float hq = 0.f, aq = 1.f;
#pragma unroll
        for (int k = 0; k < 16; ++k) { hq = av[k] * hq + bv[k]; aq *= av[k]; }
        float c = carry_in, atot = 1.f, cme = carry_in;
#pragma unroll
        for (int sg = 0; sg < 4; ++sg) {
            const float as_ = shx(aq, 0, (tid & ~3) | sg), hs_ = shx(hq, 0, (tid & ~3) | sg);
            if (seg == sg) cme = c;
            c = as_ * c + hs_; atot *= as_;
        }
        float hc = cme;
#pragma unroll
        for (int k = 0; k < 16; ++k) { const int ii = seg * 16 + k, i = dir ? 63 - ii : ii; hc = av[k] * hc + bv[k]; Bb[(dir * 64 + i) * 65 + n] = hc; }
        if (pass == 1 && !dry && seg == 0) { sum[0] = atot; sum[256] = c; }
    }
    if (pass == 2) {
        RAW_BAR();
        float y[8], o[8]; unpack8(yaw, y);
#pragma unroll
        for (int j = 0; j < 8; ++j) o[j] = (Bb[row * 65 + ch8 + j] + Bb[(64 + row) * 65 + ch8 + j]) * gelu_tanh(y[j]);
        if (!dry) *(u32x4*)(U + (size_t)(t0 + row) * LDU + UC_YA + h * 64 + ch8) = pack8(o);
    }
    RAW_BAR();
}
__device__ __forceinline__ void mixA_scan(KArgs a, int s, int tid, bool dry) {
    asm volatile("" : "+v"(tid));
    const int dir = tid >> 8, ch = tid & 255;
    const int c0 = s < 4 ? 128 * s : 512, n = s < 4 ? 128 : 256;
    float* AS = (float*)(a->ws + WS_ASUM);
    float carry = 0.f;
    for (int nb = 0; nb < n; nb += 16) {
        float av[16], bv[16];
#pragma unroll
        for (int j = 0; j < 16; ++j) { const int gc = dir ? c0 + n - 1 - (nb + j) : c0 + nb + j; const float* p = AS + ((size_t)(gc * 2 + dir) * 2) * 256 + ch; av[j] = p[0]; bv[j] = p[256]; }
#pragma unroll
        for (int j = 0; j < 16; ++j) { const int gc = dir ? c0 + n - 1 - (nb + j) : c0 + nb + j; float* p = AS + ((size_t)(gc * 2 + dir) * 2) * 256 + ch;
            if (!dry) p[256] = carry; carry = av[j] * carry + bv[j]; }
    }
}
__device__ __forceinline__ int kpos(int k) { const int x = k & 31, xx = x & 15; return (k & ~31) + ((xx >> 2) << 3) + ((x >> 4) << 2) + (xx & 3); }

__device__ __forceinline__ void mixB_local(KArgs a, int l, int gc, int h, int tid, bool dry) {
    asm volatile("" : "+s"(l));
    unsigned char* lds = lds_dyn;
    asm volatile("" : "+v"(tid));
    bf16_t* U = (bf16_t*)(a->ws + WS_U); const bf16_t* HB = (const bf16_t*)(a->ws + WS_HB);
    float* Xf = (float*)lds;
    bf16_t* Qh = (bf16_t*)(lds + 49920); bf16_t* Kh = Qh + 64 * 72;
    bf16_t* KKh = Kh + 64 * 72; bf16_t* QKh = KKh + 64 * 72;
    float* Lf = (float*)(lds + 86784);
    bf16_t* solT = (bf16_t*)(lds + 103168);
    float* Osum = (float*)(lds + 121600);
    float* bet = (float*)(lds + 138240); float* gcm = bet + 64; float* eg = gcm + 64;
    float* Bt = (float*)(lds + 139008); float* Gt = Bt + 128;
    float* Cw = (float*)(lds + 140032);
    bf16_t* Raw = (bf16_t*)(lds + 86784);
    const int lane = tid & 63, wave = tid >> 6;
    const int t0 = gc * 64, ts = seq_start_tok(t0), te = seq_end_tok(t0);
    {
        const u32x4 z4 = {0u, 0u, 0u, 0u};
#pragma unroll
        for (int it = 0; it < 4; ++it) {
            const int idx = tid + 512 * it;
            if (idx < 1608) {
                const int rr = idx / 24, pc = idx % 24, t = t0 - 2 + rr, col = (pc >> 3) * 256 + h * 64 + (pc & 7) * 8;
                u32x4 v = z4;
                if (t >= ts && t < te) {
                    if (rr < 2) v = *(const u32x4*)(HB + ((size_t)(gc - 1) * 3 + 1 + rr) * 768 + col);
                    else if (rr == 66) v = *(const u32x4*)(HB + ((size_t)(gc + 1) * 3) * 768 + col);
                    else v = *(const u32x4*)(U + (size_t)t * LDU + UC_QB + col);
                }
                *(u32x4*)(Raw + rr * 200 + (pc >> 3) * 64 + (pc & 7) * 8) = v;
            }
        }
        const float* cwg = a->in[I_GCONV] + l * 3072;
        for (int i = tid; i < 768; i += 512) { const int j = i / 192, cc = i % 192; Cw[i] = cwg[j * 768 + (cc >> 6) * 256 + h * 64 + (cc & 63)]; }
        if (tid < 128) {
            const int dir = tid >> 6, i = tid & 63, tok = t0 + (dir ? 63 - i : i);
            const float* bap = (const float*)(a->ws + WS_BA) + (size_t)tok * 16 + dir * 4 + h;
            Bt[tid] = sigmoidf_(bap[0]);
            Gt[tid] = -__expf(a->in[I_GALOG][l * 8 + dir * 4 + h]) * softplusf_(bap[8] + a->in[I_GDT][l * 8 + dir * 4 + h]);
        }
        for (int idx = tid; idx < 64 * 65; idx += 512) Osum[idx] = 0.f;
    }
    RAW_BAR();
#pragma unroll 4
    for (int idx = tid; idx < 64 * 192; idx += 512) {
        const int i = idx / 192, cc = idx % 192;
        const float acc = Cw[cc] * bf2f(Raw[i * 200 + cc]) + Cw[192 + cc] * bf2f(Raw[(i + 1) * 200 + cc]) + Cw[384 + cc] * bf2f(Raw[(i + 2) * 200 + cc]) + Cw[576 + cc] * bf2f(Raw[(i + 3) * 200 + cc]);
        Xf[((cc >> 6) * 64 + i) * 65 + (cc & 63)] = siluf_(acc);
    }
    RAW_BAR();
    {
        const int part = tid >> 8, i = (tid >> 2) & 63, sub = tid & 3; float* x = Xf + (part * 64 + i) * 65 + sub * 16; float ss = 0.f;
#pragma unroll
        for (int d = 0; d < 16; ++d) ss += x[d] * x[d];
        ss += shx(ss, 1, tid); ss += shx(ss, 2, tid);
        const float inv = (part == 0 ? 0.125f : 1.f) / sqrtf(ss + EPS);
        bf16_t* hh = (part == 0 ? Qh : Kh) + i * 72 + sub * 16;
#pragma unroll
        for (int d = 0; d < 16; ++d) { const float v = x[d] * inv; x[d] = v; hh[d] = (bf16_t)f2bf(v); }
    }
    RAW_BAR();
    const int c = lane & 15, q = lane >> 4;
    {
        const bf16_t* A = wave < 4 ? Kh : Qh; bf16_t* O = wave < 4 ? KKh : QKh;
#pragma unroll
        for (int s = 0; s < 4; ++s) { const int tile = (wave & 3) * 4 + s, rt = tile >> 2, ct = tile & 3;
            f32x4 z = {0.f, 0.f, 0.f, 0.f};
#pragma unroll
            for (int kb = 0; kb < 2; ++kb) z = mfma16(*(const bf16x8*)(A + (16 * rt + c) * 72 + kb * 32 + 8 * q), *(const bf16x8*)(Kh + (16 * ct + c) * 72 + kb * 32 + 8 * q), z);
#pragma unroll
            for (int j = 0; j < 4; ++j) O[(16 * rt + 4 * q + j) * 72 + 16 * ct + c] = (bf16_t)f2bf(z[j]); }
    }
    RAW_BAR();
    bf16_t* attnh = Qh; bf16_t* kgT = Kh;
    bf16_t* MN = (bf16_t*)(a->ws + WS_MN); float* DEC = (float*)(a->ws + WS_DEC);
#pragma unroll 1
    for (int dir = 0; dir < 2; ++dir) {
        const size_t unit = (size_t)(gc * 4 + h) * 2 + dir;
        if (tid < 64) {
            float g = Gt[dir * 64 + tid];
#pragma unroll
            for (int o = 1; o < 64; o <<= 1) { const float t = __builtin_bit_cast(float, __builtin_amdgcn_ds_bpermute(((tid - o) & 63) << 2, __builtin_bit_cast(int, g))); if (tid >= o) g += t; }
            bet[tid] = Bt[dir * 64 + tid]; gcm[tid] = g; eg[tid] = __expf(g);
            if (tid == 63 && !dry) DEC[unit] = __expf(g);
        }
        RAW_BAR();
        const float gl = gcm[63];
        for (int idx = tid; idx < 4096; idx += 512) {
            const int i = idx & 63, j = idx >> 6, ri = dir ? 63 - i : i, rj = dir ? 63 - j : j;
            const float dec = j <= i ? __expf(gcm[i] - gcm[j]) : 0.f;
            Lf[j * 64 + i] = j < i ? bet[i] * bf2f(KKh[ri * 72 + rj]) * dec : 0.f;
            attnh[i * 72 + j] = (bf16_t)f2bf(bf2f(QKh[ri * 72 + rj]) * dec);
            kgT[i * 72 + j] = (bf16_t)f2bf(Xf[(64 + rj) * 65 + i] * __expf(gl - gcm[j]));
        }
        RAW_BAR();
        {
            const int g = lane & 3, col = wave * 16 + (lane >> 2); bf16_t* xrow = solT + col * 72;
            const float* xsrc = col < 64 ? Xf + 128 * 65 + col : Xf + 64 * 65 + (col - 64);
#pragma unroll 1
            for (int b = 0; b < 4; ++b) {
                float r[4];
#pragma unroll
                for (int e = 0; e < 4; ++e) { const int i = 16 * b + 4 * g + e, ri = dir ? 63 - i : i; r[e] = xsrc[ri * 65] * bet[i] * (col < 64 ? 1.f : eg[i]); }
#pragma unroll 1
                for (int j0 = 0; j0 < 16 * b; j0 += 8) {
                    float xv[8]; unpack8(*(const u32x4*)(xrow + j0), xv);
#pragma unroll
                    for (int jj = 0; jj < 8; ++jj) { const f32x4 lv = *(const f32x4*)(Lf + (j0 + jj) * 64 + 16 * b + 4 * g);
                        r[0] -= lv[0] * xv[jj]; r[1] -= lv[1] * xv[jj]; r[2] -= lv[2] * xv[jj]; r[3] -= lv[3] * xv[jj]; }
                }
#pragma unroll
                for (int gs = 0; gs < 4; ++gs) {
                    if (g == gs) {
                        const float* lp = Lf + (16 * b + 4 * g) * 64 + 16 * b + 4 * g;
                        r[1] -= lp[1] * r[0];
                        r[2] -= lp[2] * r[0] + lp[64 + 2] * r[1];
                        r[3] -= lp[3] * r[0] + lp[64 + 3] * r[1] + lp[128 + 3] * r[2];
                    }
                    if (gs < 3) {
                        float xp[4];
#pragma unroll
                        for (int e = 0; e < 4; ++e) xp[e] = __builtin_bit_cast(float, __builtin_amdgcn_ds_bpermute((((tid & ~3) | gs) & 63) << 2, __builtin_bit_cast(int, r[e])));
                        if (g > gs) {
#pragma unroll
                            for (int pp = 0; pp < 4; ++pp) { const f32x4 lv = *(const f32x4*)(Lf + (16 * b + 4 * gs + pp) * 64 + 16 * b + 4 * g);
                                r[0] -= lv[0] * xp[pp]; r[1] -= lv[1] * xp[pp]; r[2] -= lv[2] * xp[pp]; r[3] -= lv[3] * xp[pp]; }
                        }
                    }
                }
                u32x2 wv2; wv2.x = pk2(r[0], r[1]); wv2.y = pk2(r[2], r[3]);
                *(u32x2*)(xrow + 16 * b + 4 * g) = wv2;
            }
        }
        RAW_BAR();
        {
            const int rt = wave & 3; const bf16_t* A = wave < 4 ? attnh : kgT;
            const bf16x8 a0 = *(const bf16x8*)(A + (16 * rt + c) * 72 + 8 * q), a1 = *(const bf16x8*)(A + (16 * rt + c) * 72 + 32 + 8 * q);
#pragma unroll 1
            for (int ct = 0; ct < 8; ++ct) {
                f32x4 z = {0.f, 0.f, 0.f, 0.f};
                z = mfma16(a0, *(const bf16x8*)(solT + (16 * ct + c) * 72 + 8 * q), z);
                z = mfma16(a1, *(const bf16x8*)(solT + (16 * ct + c) * 72 + 32 + 8 * q), z);
                if (wave < 4) {
                    if (ct < 4) {
#pragma unroll
                        for (int j = 0; j < 4; ++j) { const int i = 16 * rt + 4 * q + j, ri = dir ? 63 - i : i; Osum[ri * 65 + 16 * ct + c] += z[j]; }
                    } else {
                        const int dk = 16 * (ct - 4) + c, pp = kpos(dk);
#pragma unroll
                        for (int j = 0; j < 4; ++j) { const int i = 16 * rt + 4 * q + j, ri = dir ? 63 - i : i;
                            const bf16_t ov = (bf16_t)f2bf(Xf[ri * 65 + dk] * eg[i] - z[j]); if (!dry) U[(size_t)(t0 + ri) * LDU + (dir ? UC_KB : UC_QB) + h * 64 + pp] = ov; }
                    }
                } else {
                    if (ct < 4) {
                        u32x2 w; w.x = pk2(z[0], z[1]); w.y = pk2(z[2], z[3]);
                        if (!dry) *(u32x2*)(MN + unit * 8192 + 4096 + (16 * ct + c) * 64 + 16 * rt + 4 * q) = w;
                    } else {
                        const int pp = kpos(16 * (ct - 4) + c);
#pragma unroll
                        for (int j = 0; j < 4; ++j) if (!dry) MN[unit * 8192 + (16 * rt + 4 * q + j) * 64 + pp] = (bf16_t)f2bf(z[j]);
                    }
                }
            }
        }
        RAW_BAR();
    }
    { const int row = tid >> 3, ch8 = (tid & 7) * 8; if (!dry) *(u32x4*)(U + (size_t)(t0 + row) * LDU + UC_VB + h * 64 + ch8) = pack8(Osum + row * 65 + ch8); }
    RAW_BAR();
}

__device__ __forceinline__ void mixB_chain(KArgs a, int s, int h, int dir, int tid, bool dry) {
    unsigned char* lds = lds_dyn;
    asm volatile("" : "+v"(tid));
    bf16_t* U = (bf16_t*)(a->ws + WS_U);
    const bf16_t* MN = (const bf16_t*)(a->ws + WS_MN); const float* DEC = (const float*)(a->ws + WS_DEC);
    const int lane = tid & 63, wave = tid >> 6, w = wave & 3, hf = wave >> 2, c = lane & 15, q = lane >> 4;
    const int c0 = s < 4 ? 128 * s : 512, n = s < 4 ? 128 : 256;
    const int slot = (dir ? UC_KB : UC_QB) + h * 64;
    bf16_t* Sbuf = (bf16_t*)lds;
    for (int i = tid; i < 2 * 64 * 72 / 2; i += 512) ((unsigned*)Sbuf)[i] = 0u;
    constexpr int PFD = 4;
    f32x4 S[2];
    S[0] = (f32x4){0.f, 0.f, 0.f, 0.f}; S[1] = (f32x4){0.f, 0.f, 0.f, 0.f};
    bf16x8 Mq[PFD][2], Qq[PFD][2]; u32x2 Nq[PFD][2]; float dq[PFD];
    const int irow = 16 * w + c, rirow = dir ? 63 - irow : irow;
#define MIXB_LOAD(k, step) do { const int gc_ = dir ? c0 + n - 1 - (step) : c0 + (step); const size_t unit_ = (size_t)(gc_ * 4 + h) * 2 + dir; const bf16_t* Mp = MN + unit_ * 8192; \
        _Pragma("unroll") for (int kb = 0; kb < 2; ++kb) { Mq[k][kb] = *(const bf16x8*)(Mp + irow * 64 + kb * 32 + 8 * q); \
            Qq[k][kb] = *(const bf16x8*)(U + (size_t)(gc_ * 64 + rirow) * LDU + slot + kb * 32 + 8 * q); } \
        _Pragma("unroll") for (int t = 0; t < 2; ++t) Nq[k][t] = *(const u32x2*)(Mp + 4096 + (16 * (2 * hf + t) + c) * 64 + 16 * w + 4 * q); \
        dq[k] = DEC[unit_]; } while (0)
#pragma unroll
    for (int k = 0; k < PFD; ++k) MIXB_LOAD(k, k);
    RAW_BAR();
#pragma unroll 1
    for (int step0 = 0; step0 < n; step0 += PFD) {
#pragma unroll
        for (int k = 0; k < PFD; ++k) {
            const int step = step0 + k, p = k & 1;
            const bf16_t* Sr = Sbuf + p * (64 * 72); bf16_t* Sw = Sbuf + (p ^ 1) * (64 * 72);
            bf16x8 Sf[2][2];
#pragma unroll
            for (int t = 0; t < 2; ++t)
#pragma unroll
                for (int kb = 0; kb < 2; ++kb) Sf[t][kb] = *(const bf16x8*)(Sr + (16 * (2 * hf + t) + c) * 72 + 32 * kb + 8 * q);
            f32x4 cr[2];
#pragma unroll
            for (int t = 0; t < 2; ++t) {
                f32x4 ns = {0.f, 0.f, 0.f, 0.f}, z = {0.f, 0.f, 0.f, 0.f};
                ns = mfma16(Mq[k][0], Sf[t][0], ns); ns = mfma16(Mq[k][1], Sf[t][1], ns);
                z = mfma16(Sf[t][0], Qq[k][0], z); cr[t] = mfma16(Sf[t][1], Qq[k][1], z);
                const f32x4 nn = {bflo(Nq[k][t].x), bfhi(Nq[k][t].x), bflo(Nq[k][t].y), bfhi(Nq[k][t].y)};
                S[t] = S[t] * dq[k] - ns + nn;
                u32x2 sw; sw.x = pg8::cvt_pk_bf16(S[t][0], S[t][1]); sw.y = pg8::cvt_pk_bf16(S[t][2], S[t][3]);
                *(u32x2*)(Sw + (16 * (2 * hf + t) + c) * 72 + 32 * (w >> 1) + 8 * q + 4 * (w & 1)) = sw;
            }
            u32x2 cp[2];
#pragma unroll
            for (int t = 0; t < 2; ++t) { cp[t].x = pg8::cvt_pk_bf16(cr[t][0], cr[t][1]); cp[t].y = pg8::cvt_pk_bf16(cr[t][2], cr[t][3]); asm volatile("" :: "v"(cp[t].x), "v"(cp[t].y)); }
            const int gc = dir ? c0 + n - 1 - step : c0 + step;
            if (step + PFD < n) MIXB_LOAD(k, step + PFD);
            RAW_BAR();
#pragma unroll
            for (int t = 0; t < 2; ++t) if (!dry) *(u32x2*)(U + (size_t)(gc * 64 + rirow) * LDU + slot + 16 * (2 * hf + t) + 4 * q) = cp[t];
        }
    }
#undef MIXB_LOAD
    RAW_BAR();
}
__device__ __forceinline__ void mixB_final(KArgs a, int l, int gc, int h, int tid, bool dry) {
    asm volatile("" : "+s"(l));
    asm volatile("" : "+v"(tid));
    bf16_t* U = (bf16_t*)(a->ws + WS_U);
    const int i = tid >> 3, e0 = (tid & 7) * 8; const float* gn = a->in[I_GNORM] + l * 64;
    bf16_t* row = U + (size_t)(gc * 64 + i) * LDU + h * 64 + e0;
    float v[8], f[8], b[8], zz[8];
    unpack8(*(const u32x4*)(row + UC_VB), v); unpack8(*(const u32x4*)(row + UC_QB), f); unpack8(*(const u32x4*)(row + UC_KB), b); unpack8(*(const u32x4*)(row + UC_ZB), zz);
    float ss = 0.f;
#pragma unroll
    for (int j = 0; j < 8; ++j) { v[j] += f[j] + b[j]; ss += v[j] * v[j]; }
    ss += shx(ss, 1, tid); ss += shx(ss, 2, tid); ss += shx(ss, 4, tid);
    const float r = 1.f / sqrtf(ss * (1.f / 64.f) + EPS);
#pragma unroll
    for (int j = 0; j < 8; ++j) v[j] = v[j] * r * gn[e0 + j] * siluf_(zz[j]);
    if (!dry) *(u32x4*)(row + UC_ZB) = pack8(v);
}

#ifndef MIX_MASK
#define MIX_MASK 15
#endif
#ifndef DRY_L2
#define DRY_L2 0
#endif
#ifndef DRY_L3
#define DRY_L3 0
#endif
#ifndef DRY_L4
#define DRY_L4 0
#endif
__device__ __forceinline__ bool opaque_flag(int v) { asm volatile("" : "+s"(v)); return v != 0; }
__device__ __forceinline__ void phase_mix_local(int wv, int l) {
    asm volatile("" : "+s"(l));
    unsigned char* lds = lds_dyn;
    KArgs a = kargs();
    const int tid = tidx(wv), bid = bidx(), gd = gdim();
    for (int rep = (DRY_L2 ? 0 : 1); rep < 2; ++rep) {
        const bool dry = opaque_flag(rep == 0); const int dm = dry ? DRY_L2 : 15;
        for (int job = bid; job < 4 * 3072; job += gd) {
            const int ty = job / 3072, r = job % 3072, gc = r >> 2, h = r & 3;
            if (ty == 0) { }
            else if (ty == 1) { if ((MIX_MASK & 4) && (dm & 2)) mixC_local(a, l, gc, h, tid, dry); }
            else if (ty == 2) { if ((MIX_MASK & 1) && (dm & 4)) mixA_job(a, l, gc, h, 1, tid, dry); }
            else { if ((MIX_MASK & 2) && (dm & 8)) mixB_local(a, l, gc, h, tid, dry); }
        }
    }
}
__device__ __forceinline__ void phase_mix_scan(int wv, int l) {
    asm volatile("" : "+s"(l));
    unsigned char* lds = lds_dyn;
    KArgs a = kargs();
    const int tid = tidx(wv), bid = bidx(), gd = gdim();
    for (int rep = (DRY_L3 ? 0 : 1); rep < 2; ++rep) {
        const bool dry = opaque_flag(rep == 0); const int dm = dry ? DRY_L3 : 7;
        for (int job = bid; job < 205; job += gd) {
            if (job < 40) { if ((MIX_MASK & 2) && (dm & 1)) mixB_chain(a, job >> 3, (job >> 1) & 3, job & 1, tid, dry); }
            else if (job < 45) { if ((MIX_MASK & 1) && (dm & 2)) mixA_scan(a, job - 40, tid, dry); }
            else { if ((MIX_MASK & 4) && (dm & 4)) mixC_scan(a, l, job - 45, tid, dry); }
        }
        if (!dry && (MIX_MASK & 8) && bid >= 40 && gd > 40) {
            for (int d = bid - 40; d < 3072; d += gd - 40) mixD_job(a, l, d >> 2, d & 3, tid, false);
            RAW_BAR();
            phase_weights(wv, l, 2, 40);
        }
    }
}
__device__ __forceinline__ void phase_mix_final(int wv, int l) {
    asm volatile("" : "+s"(l));
    unsigned char* lds = lds_dyn;
    KArgs a = kargs();
    const int tid = tidx(wv), bid = bidx(), gd = gdim();
    bf16_t* U = (bf16_t*)(a->ws + WS_U);
    for (int rep = (DRY_L4 ? 0 : 1); rep < 2; ++rep) {
        const bool dry = opaque_flag(rep == 0); const int dm = dry ? DRY_L4 : 7;
        for (int job = bid; job < 3 * 3072; job += gd) {
            const int ty = job / 3072, r = job % 3072, gc = r >> 2, h = r & 3;
            if (ty == 0) { if ((MIX_MASK & 4) && (dm & 1)) mixC_final(a, l, gc, h, tid, dry); }
            else if (ty == 1) { if ((MIX_MASK & 1) && (dm & 2)) mixA_job(a, l, gc, h, 2, tid, dry); }
            else { if ((MIX_MASK & 2) && (dm & 4)) mixB_final(a, l, gc, h, tid, dry); }
        }
    }
    for (int m = 0; m < 4; ++m) {
        const int bit = m == 0 ? 1 : (m == 1 ? 2 : (m == 2 ? 4 : 8));
        if (MIX_MASK & bit) continue;
        for (int idx = bid * 512 + tid; idx < M_TOK * 32; idx += gd * 512) { const int t = idx >> 5, c8 = (idx & 31) * 8; *(u32x4*)(U + (size_t)t * LDU + m * 256 + c8) = (u32x4){0u, 0u, 0u, 0u}; }
    }
}
#ifndef MIX_MASK
#define MIX_MASK 15
#endif
__global__ void __launch_bounds__(512, 2) fwd_megakernel(Args a) {
    unsigned nbar = 0u;
    int wv = __builtin_amdgcn_readfirstlane(threadIdx.x >> 6);
    int vcu = blockIdx.x;
    {
        const int xcc = (int)(__builtin_amdgcn_s_getreg((3 << 11) | 20) & 7u);
        unsigned* cen = (unsigned*)(kargs()->ws + WS_BAR) + 16;
        volatile unsigned* lw = (volatile unsigned*)(lds_dyn + 147456 - 16);
        if (threadIdx.x == 0) lw[0] = (__hip_atomic_fetch_add(cen + xcc, 1u, __ATOMIC_RELAXED, __HIP_MEMORY_SCOPE_AGENT) << 3) | (unsigned)xcc;
        __syncthreads();
        vcu = __builtin_amdgcn_readfirstlane((int)lw[0]);
    }

    for (int l = 0; l < 2; ++l) {
        phase_weights(wv, l, 1);
        phase_norm(wv, l, (l == 0 ? 1 : 0) | 2);
        if (l == 0) { GSYNC_CG();
            const unsigned* cen = (const unsigned*)(kargs()->ws + WS_BAR) + 16; bool even = (gridDim.x & 7) == 0;
            for (int j = 0; j < 8; ++j) even = even && (__hip_atomic_load(cen + j, __ATOMIC_RELAXED, __HIP_MEMORY_SCOPE_AGENT) == gridDim.x / 8);
            vcu = __builtin_amdgcn_readfirstlane(even ? vcu : (int)blockIdx.x); }
        else GSYNC();
        { KArgs ka = kargs(); unsigned char* ws = ka->ws; int G = gridDim.x, bx = __builtin_amdgcn_readfirstlane(vcu); asm volatile("" : "+s"(G), "+s"(bx)); bf16_t* U = (bf16_t*)(ws + WS_U); bf16_t* XB = (bf16_t*)(ws + WS_XB); float* RS = (float*)(ws + WS_RS); (void)U; (void)XB; (void)RS;
          pg8::Gemm g{XB, (const bf16_t*)(ws + WS_WIN), M_TOK, LDU, DM, DM}; pg8::StaticOrder S; S.init(M_TOK, LDU, G, bx);
          pg8::EpiU E{U, RS, (bf16_t*)(ws + WS_HB)};
          pg8::gemm_phase<pg8::EpiU, pg8::StaticOrder, true>((PG8_LAS unsigned char*)lds_dyn, g, S, E, tidx(wv)); }
        GSYNC();
#if MIX_MASK
        phase_mix_local(wv, l);
        GSYNC();
        phase_mix_scan(wv, l);
        GSYNC();
        phase_mix_final(wv, l);
        GSYNC();
        { KArgs ka = kargs(); unsigned char* ws = ka->ws; int G = gridDim.x, bx = __builtin_amdgcn_readfirstlane(vcu); asm volatile("" : "+s"(G), "+s"(bx)); bf16_t* U = (bf16_t*)(ws + WS_U); bf16_t* XB = (bf16_t*)(ws + WS_XB); float* RS = (float*)(ws + WS_RS); (void)U; (void)XB; (void)RS;
          pg8::Gemm g{U, (const bf16_t*)(ws + WS_WOUT), M_TOK, DM, DM, LDU}; pg8::StaticOrder S; S.init(M_TOK, DM, G, bx);
          pg8::EpiResN E{ka->out, XB, (float*)(ws + WS_SS2), l == 0 ? ka->in[I_XP] : nullptr, ka->in[I_XS]};
          pg8::gemm_phase<pg8::EpiResN, pg8::StaticOrder, true>((PG8_LAS unsigned char*)lds_dyn, g, S, E, tidx(wv)); }
        GSYNC();
#endif
        for (int hf = 0; hf < 3; ++hf) {
            const int row0 = hf * MH;
            { KArgs ka = kargs(); unsigned char* ws = ka->ws; int G = gridDim.x, bx = __builtin_amdgcn_readfirstlane(vcu); asm volatile("" : "+s"(G), "+s"(bx)); bf16_t* U = (bf16_t*)(ws + WS_U); bf16_t* XB = (bf16_t*)(ws + WS_XB); float* RS = (float*)(ws + WS_RS); (void)U; (void)XB; (void)RS;
              pg8::Gemm g{XB + (size_t)row0 * DM, (const bf16_t*)(ws + WS_WGU), MH, 2 * DFF, DM, DM}; pg8::StaticOrder S; S.init(MH, 2 * DFF, G, bx);
              pg8::EpiGU E{(bf16_t*)(ws + WS_G), (bf16_t*)(ws + WS_UP), RS + row0, (const float*)(ws + WS_SS2) + (size_t)row0 * 16};
              pg8::gemm_phase<pg8::EpiGU, pg8::StaticOrder, true>((PG8_LAS unsigned char*)lds_dyn, g, S, E, tidx(wv)); }
            GSYNC();
            phase_ffn_elem(wv, l, row0);
            if (hf == 2) phase_pconv(wv, l);
            GSYNC();
            { KArgs ka = kargs(); unsigned char* ws = ka->ws; int G = gridDim.x, bx = __builtin_amdgcn_readfirstlane(vcu); asm volatile("" : "+s"(G), "+s"(bx)); bf16_t* U = (bf16_t*)(ws + WS_U); bf16_t* XB = (bf16_t*)(ws + WS_XB); float* RS = (float*)(ws + WS_RS); (void)U; (void)XB; (void)RS;
              pg8::Gemm g{(const bf16_t*)(ws + WS_UP), (const bf16_t*)(ws + WS_WD), MH, DM, DFF, DFF}; pg8::StaticOrder S; S.init(MH, DM, G, bx);
              pg8::EpiResN E{ka->out + (size_t)row0 * DM, XB + (size_t)row0 * DM, (float*)(ws + WS_SS3) + (size_t)row0 * 16, nullptr, nullptr};
              pg8::gemm_phase<pg8::EpiResN, pg8::StaticOrder, true>((PG8_LAS unsigned char*)lds_dyn, g, S, E, tidx(wv)); }
            if (hf == 2) {
              KArgs ka = kargs(); unsigned char* ws = ka->ws; int G = gridDim.x, bx = __builtin_amdgcn_readfirstlane(vcu); asm volatile("" : "+s"(G), "+s"(bx)); bf16_t* U = (bf16_t*)(ws + WS_U); bf16_t* XB = (bf16_t*)(ws + WS_XB); float* RS = (float*)(ws + WS_RS); (void)U; (void)XB; (void)RS;
              pg8::Gemm g{(const bf16_t*)(ws + WS_PB), (const bf16_t*)(ws + WS_WPP), M_TOK, DM, PLED, PLED}; pg8::StaticOrder S; S.init(M_TOK, DM, G, bx);
              pg8::EpiP E{(bf16_t*)(ws + WS_P)};
              pg8::gemm_phase<pg8::EpiP, pg8::StaticOrder, true>((PG8_LAS unsigned char*)lds_dyn, g, S, E, tidx(wv)); }
            GSYNC();
        }
        { KArgs ka = kargs(); unsigned char* ws = ka->ws; int G = gridDim.x, bx = __builtin_amdgcn_readfirstlane(vcu); asm volatile("" : "+s"(G), "+s"(bx)); bf16_t* U = (bf16_t*)(ws + WS_U); bf16_t* XB = (bf16_t*)(ws + WS_XB); float* RS = (float*)(ws + WS_RS); (void)U; (void)XB; (void)RS;
          pg8::Gemm g{XB, (const bf16_t*)(ws + WS_WPG), M_TOK, DM, DM, DM}; pg8::StaticOrder S; S.init(M_TOK, DM, G, bx);
          pg8::EpiPle E{ka->out, (const bf16_t*)(ws + WS_P), RS, (const float*)(ws + WS_SS3)};
          pg8::gemm_phase<pg8::EpiPle, pg8::StaticOrder, true>((PG8_LAS unsigned char*)lds_dyn, g, S, E, tidx(wv)); }
        if (l == 0) GSYNC();
    }
}

extern "C" void kernel_launch(void* const* d_in, const int* in_sizes, int n_in, void* d_out, int out_size, void* d_ws, size_t ws_size, hipStream_t stream) {
    static int grid = 0;
    if (grid == 0) {
        if (n_in != 32 || out_size != M_TOK * DM || ws_size < WS_END) { fprintf(stderr, "kernel_launch: unexpected problem (n_in %d out %d ws %zu, need %zu)\n", n_in, out_size, ws_size, (size_t)WS_END); grid = -1; return; }
        int dev = 0, cus = 0, per_cu = 0;
        hipGetDevice(&dev); hipDeviceGetAttribute(&cus, hipDeviceAttributeMultiprocessorCount, dev);
        if (hipFuncSetAttribute((const void*)fwd_megakernel, hipFuncAttributeMaxDynamicSharedMemorySize, LDS_BYTES) != hipSuccess) { fprintf(stderr, "kernel_launch: hipFuncSetAttribute failed\n"); grid = -1; return; }
        if (hipOccupancyMaxActiveBlocksPerMultiprocessor(&per_cu, (const void*)fwd_megakernel, 512, LDS_BYTES) != hipSuccess || per_cu < 1) { fprintf(stderr, "kernel_launch: occupancy query says %d\n", per_cu); per_cu = 1; }
        (void)hipGetLastError();
        grid = cus * 1;
    }
    if (grid < 0) return;
    if (hipMemsetAsync((char*)d_ws + WS_BAR, 0, 256, stream) != hipSuccess) { fprintf(stderr, "kernel_launch: hipMemsetAsync failed\n"); return; }
    Args a{};
    for (int i = 0; i < 32; ++i) a.in[i] = (const float*)d_in[i];
    a.out = (float*)d_out; a.ws = (unsigned char*)d_ws;
    void* args[] = {&a};
    hipError_t e = hipLaunchCooperativeKernel((const void*)fwd_megakernel, dim3(grid), dim3(512), args, LDS_BYTES, stream);
    if (e != hipSuccess) fprintf(stderr, "cooperative launch failed: %s (grid %d)\n", hipGetErrorString(e), grid);
}
```

```cpp
#include <hip/hip_runtime.h>
#include <hip/hip_cooperative_groups.h>
#include <cstdio>
#include <cstdint>
namespace cg = cooperative_groups;

typedef unsigned short bf16_t;
typedef short bf16x8 __attribute__((ext_vector_type(8)));
typedef short bf16x4 __attribute__((ext_vector_type(4)));
typedef float f32x4 __attribute__((ext_vector_type(4)));
typedef float f32x2 __attribute__((ext_vector_type(2)));
typedef unsigned u32x4 __attribute__((ext_vector_type(4)));
typedef unsigned u32x2 __attribute__((ext_vector_type(2)));

constexpr int M_TOK = 49152, DM = 1024, LDU = 3328, DFF = 2816, PLED = 256, NCHUNK = 768, INC = 3344;
constexpr int MH = 16384;
constexpr float EPS = 1e-6f;
constexpr int UC_YA = 0, UC_ZB = 256, UC_GC = 512, UC_QD = 768, UC_XA = 1024, UC_QB = 1280, UC_KB = 1536, UC_VB = 1792,
              UC_QC = 2048, UC_KC = 2304, UC_VC = 2560, UC_KD = 2816, UC_VD = 3072;
constexpr size_t MiB = 1u << 20;
constexpr size_t WS_RS = 0;
constexpr size_t WS_DEC = 256 * 1024;
constexpr size_t WS_BAR = 384 * 1024;
constexpr size_t WS_LRU = 512 * 1024;
constexpr size_t WS_BA = 1 * MiB;
constexpr size_t WS_WIN = 4 * MiB, WS_WOUT = WS_WIN + 6656 * 1024, WS_WGU = WS_WOUT + 2 * MiB, WS_WD = WS_WGU + 11 * MiB,
                 WS_WPG = WS_WD + 5632 * 1024, WS_WPP = WS_WPG + 2 * MiB;
constexpr size_t WS_U = 32 * MiB;
constexpr size_t WS_XB = 344 * MiB;
constexpr size_t WS_T = 440 * MiB;
constexpr size_t WS_END = 512 * MiB;
constexpr size_t WS_MN = WS_XB;
constexpr size_t WS_KV = WS_XB + 96 * MiB;
constexpr size_t WS_ASUM = WS_XB + 144 * MiB;
constexpr size_t WS_HB = WS_XB + 148 * MiB;
constexpr size_t WS_SS2 = WS_XB + 152 * MiB, WS_SS3 = WS_XB + 155 * MiB;
constexpr size_t WS_G = WS_U, WS_UP = WS_U + 96 * MiB;
constexpr size_t WS_P = WS_U, WS_PB = WS_T;

__device__ __forceinline__ unsigned f2bf(float f) { unsigned u = __builtin_bit_cast(unsigned, f); return (u + 0x7fffu + ((u >> 16) & 1u)) >> 16; }
__device__ __forceinline__ unsigned pk2(float lo, float hi) { return f2bf(lo) | (f2bf(hi) << 16); }
__device__ __forceinline__ float bf2f(unsigned short b) { return __builtin_bit_cast(float, (unsigned)b << 16); }
__device__ __forceinline__ float bflo(unsigned w) { return __builtin_bit_cast(float, w << 16); }
__device__ __forceinline__ float bfhi(unsigned w) { return __builtin_bit_cast(float, w & 0xffff0000u); }
__device__ __forceinline__ float shx(float v, int mask, int lane) { return __builtin_bit_cast(float, __builtin_amdgcn_ds_bpermute(((lane ^ mask) & 63) << 2, __builtin_bit_cast(int, v))); }
__device__ __forceinline__ float wave_sum(float v, int lane) {
#pragma unroll
    for (int o = 1; o < 64; o <<= 1) v += shx(v, o, lane);
    return v;
}
__device__ __forceinline__ float sigmoidf_(float x) { return 1.f / (1.f + __expf(-x)); }
__device__ __forceinline__ float siluf_(float x) { return x / (1.f + __expf(-x)); }
__device__ __forceinline__ float gelu_tanh(float x) { const float u = 0.7978845608028654f * (x + 0.044715f * x * x * x); return x / (1.f + __expf(-2.f * u)); }
__device__ __forceinline__ float log1p_small(float x) { return x * (1.f + x * (-0.5f + x * (0.33333334f + x * (-0.25f + x * (0.2f + x * (-0.16666667f + x * 0.14285715f)))))); }
__device__ __forceinline__ float softplusf_(float x) { if (x > 20.f) return x; const float e = __expf(x); return e < 0.05f ? log1p_small(e) : __logf(1.f + e); }
__device__ __forceinline__ float neg_expm1(float t) { return fabsf(t) < 0.25f ? -t * (1.f + t * (0.5f + t * (0.16666667f + t * (0.041666668f + t * (0.008333334f + t * (0.0013888889f + t * 0.0001984127f)))))) : 1.f - __expf(t); }
__device__ __forceinline__ int seq_start_tok(int t) { return t < 32768 ? (t & ~8191) : 32768; }
__device__ __forceinline__ int seq_end_tok(int t) { return t < 32768 ? (t & ~8191) + 8192 : 49152; }
__device__ __forceinline__ f32x4 mfma16(bf16x8 a, bf16x8 b, f32x4 c) { return __builtin_amdgcn_mfma_f32_16x16x32_bf16(a, b, c, 0, 0, 0); }
extern __shared__ __attribute__((aligned(16))) unsigned char lds_dyn[];
#define LDSW() asm volatile("s_waitcnt lgkmcnt(0)" ::: "memory")

namespace pg8 {
#define PG8_LAS __attribute__((address_space(3)))
constexpr int BM = 256, BK = 64, HALF = 128, HTB = HALF * BK * 2, NXCD = 8, WGM = 8;
__host__ __device__ __forceinline__ int lds_byte(int r, int c) { const int st = (r >> 4) * 2 + (c >> 5), rr = r & 15, cc = c & 31, ob = rr * 64 + cc * 2; return st * 1024 + (ob ^ (((ob >> 9) & 1) << 5)); }
__host__ __device__ __forceinline__ void stage_rc(int b, int& R, int& C) { const int st = b / 1024, sb = b % 1024, swz = sb ^ (((sb >> 9) & 1) << 5); R = (st >> 1) * 16 + swz / 64; C = (st & 1) * 32 + (swz % 64) / 2; }
__host__ __device__ __forceinline__ int perm32(int rho) { const int n = rho >> 4, i = rho & 15; return 8 * (i >> 2) + 4 * n + (i & 3); }
struct Unit { int pm, pn; };
struct Gemm { const bf16_t* A; const bf16_t* Bt; int M, N, K, lda; };
struct StaticOrder {
    int nM, nN, nwg, G, c;
    __host__ __device__ void init(int M, int N, int G_, int c_) { nM = M / BM; nN = N / BM; nwg = nM * nN; G = G_; c = c_; }
    __host__ __device__ bool next(int i, Unit& u) const {
        const long L = (long)i * G + c; if (L >= nwg) return false;
        int wgid = (int)L; { const int q = nwg / NXCD, r = nwg % NXCD, xcd = wgid % NXCD, off = wgid / NXCD; wgid = (xcd < r ? xcd * (q + 1) : r * (q + 1) + (xcd - r) * q) + off; }
        const int nig = WGM * nN, gid = wgid / nig, fm = gid * WGM, gsz = (nM - fm) < WGM ? (nM - fm) : WGM;
        u.pm = fm + ((wgid % nig) % gsz); u.pn = (wgid % nig) / gsz; return true;
    }
    __device__ __forceinline__ void a_ready(const Unit&) const {}
    __device__ __forceinline__ void done(const Unit&) const {}
};
__device__ __forceinline__ unsigned cvt_pk_bf16(float lo, float hi) { unsigned r; asm("v_cvt_pk_bf16_f32 %0, %1, %2" : "=v"(r) : "v"(lo), "v"(hi)); return r; }

template <class Epi, class Sched, bool ALIGN_EPI = false>
__device__ __forceinline__ void gemm_phase(PG8_LAS unsigned char* lds, const Gemm g, const Sched& S, const Epi& E, int tid_in) {
    int tidq = tid_in; asm volatile("" : "+v"(tidq));
    const int tid = tidq, wid = __builtin_amdgcn_readfirstlane(tid >> 6), lane = tid & 63, wr = wid >> 2, wc = wid & 3, fr = lane & 15, fq = lane >> 4;
    int Kq = g.K; asm volatile("" : "+s"(Kq));
    const int K = Kq, nt = K / BK, lda = g.lda;
    unsigned voffA[2], voffB[2];
#pragma unroll
    for (int i = 0; i < 2; ++i) { int R, C; stage_rc(tid * 16 + i * 8192, R, C); const int Rb = Epi::PERM ? ((R & ~31) + perm32(R & 31)) : R;
        voffA[i] = (unsigned)(R * lda + C) * 2u; voffB[i] = (unsigned)(Rb * K + C) * 2u; }
    const size_t kstep = (size_t)(BK * 2);
    const size_t hstepA = (size_t)HALF * lda * 2, hstepB = (size_t)HALF * K * 2;
    const size_t tstepA = 2 * hstepA, tstepB = 2 * hstepB;
    const unsigned ldsw = (unsigned)wid * 1024u;
    const int aoff = lds_byte(wr * 64 + fr, fq * 8), boff = lds_byte(wc * 32 + fr, fq * 8);
#define PG8_SA(b, h) (((b) * 2 + (h)) * HTB)
#define PG8_SB(b, h) ((4 + (b) * 2 + (h)) * HTB)
#define PG8_STAGE(bufoff, gbase, voff) do { _Pragma("unroll") for (int _i = 0; _i < 2; ++_i) \
        __builtin_amdgcn_global_load_lds((const unsigned*)((const char*)(gbase) + (voff)[_i]), (PG8_LAS unsigned*)(lds + (bufoff) + ldsw + _i * 8192), 16, 0, 0); } while (0)
#define PG8_LDA(dst, b, h) do { _Pragma("unroll") for (int m = 0; m < 4; ++m) _Pragma("unroll") for (int k = 0; k < 2; ++k) dst[m][k] = *(const PG8_LAS bf16x8*)(lds + PG8_SA(b, h) + aoff + m * 2048 + k * 1024); } while (0)
#define PG8_LDB(dst, b, h) do { _Pragma("unroll") for (int n = 0; n < 2; ++n) _Pragma("unroll") for (int k = 0; k < 2; ++k) dst[n][k] = *(const PG8_LAS bf16x8*)(lds + PG8_SB(b, h) + boff + n * 2048 + k * 1024); } while (0)
#define PG8_MMA(ai, bj, At, Bt) do { __builtin_amdgcn_s_setprio(1); _Pragma("unroll") for (int m = 0; m < 4; ++m) _Pragma("unroll") for (int n = 0; n < 2; ++n) _Pragma("unroll") for (int k = 0; k < 2; ++k) \
        acc[ai][bj][m][n] = __builtin_amdgcn_mfma_f32_16x16x32_bf16(Bt[n][k], At[m][k], acc[ai][bj][m][n], 0, 0, 0); __builtin_amdgcn_s_setprio(0); } while (0)
#define PG8_WAIT_V(n) asm volatile("s_waitcnt vmcnt(" #n ")" ::: "memory")
#define PG8_WAIT_L(n) asm volatile("s_waitcnt lgkmcnt(" #n ")" ::: "memory")
#define PG8_BAR __builtin_amdgcn_s_barrier()
#define PG8_SCHED __builtin_amdgcn_sched_barrier(0)
    Unit cur, nxt; int ui = 0;
    if (!S.next(0, cur)) return;
    f32x4 acc[2][2][4][2];
#pragma unroll
    for (int a = 0; a < 2; ++a)
#pragma unroll
        for (int b = 0; b < 2; ++b)
#pragma unroll
            for (int m = 0; m < 4; ++m)
#pragma unroll
                for (int n = 0; n < 2; ++n) acc[a][b][m][n] = (f32x4){0.f, 0.f, 0.f, 0.f};
    bf16x8 At[4][2], B0[2][2], B1[2][2];
    const char* cA = (const char*)g.A + (size_t)cur.pm * tstepA; const char* cB = (const char*)g.Bt + (size_t)cur.pn * tstepB;
    PG8_STAGE(PG8_SB(0, 0), cB, voffB); PG8_STAGE(PG8_SB(0, 1), cB + hstepB, voffB); PG8_STAGE(PG8_SA(0, 0), cA, voffA); PG8_STAGE(PG8_SA(0, 1), cA + hstepA, voffA);
    if (wr == 1) PG8_BAR;
    PG8_WAIT_V(2); PG8_BAR;
    PG8_STAGE(PG8_SB(1, 0), cB + kstep, voffB); PG8_STAGE(PG8_SA(1, 0), cA + kstep, voffA); PG8_STAGE(PG8_SB(1, 1), cB + hstepB + kstep, voffB);
    PG8_WAIT_V(6); PG8_BAR;
    for (;;) {
        const bool has_next = S.next(ui + 1, nxt);
        const char* nA = has_next ? (const char*)g.A + (size_t)nxt.pm * tstepA : cA; const char* nB = has_next ? (const char*)g.Bt + (size_t)nxt.pn * tstepB : cB;
        for (int t = 0; t < nt; t += 2) {
            const bool last = (t == nt - 2);
            const char* a1 = cA + (size_t)(t + 1) * kstep;
            const char* a2 = last ? nA : cA + (size_t)(t + 2) * kstep; const char* b2 = last ? nB : cB + (size_t)(t + 2) * kstep;
            const char* a3 = a2 + kstep; const char* b3 = b2 + kstep;
            PG8_LDB(B0, 0, 0); PG8_LDB(B1, 0, 1); PG8_SCHED; PG8_LDA(At, 0, 0); PG8_STAGE(PG8_SA(1, 1), a1 + hstepA, voffA);
            PG8_WAIT_V(8); PG8_WAIT_L(0); PG8_BAR; PG8_MMA(0, 0, At, B0); PG8_MMA(0, 1, At, B1); PG8_BAR; PG8_SCHED;
            PG8_LDA(At, 0, 1); PG8_STAGE(PG8_SB(0, 0), b2, voffB); PG8_STAGE(PG8_SB(0, 1), b2 + hstepB, voffB); PG8_STAGE(PG8_SA(0, 0), a2, voffA);
            PG8_WAIT_V(8); PG8_WAIT_L(0); PG8_BAR; PG8_MMA(1, 0, At, B0); PG8_MMA(1, 1, At, B1); PG8_BAR; PG8_SCHED;
            PG8_LDB(B0, 1, 0); PG8_LDB(B1, 1, 1); PG8_SCHED; PG8_LDA(At, 1, 0); PG8_STAGE(PG8_SA(0, 1), a2 + hstepA, voffA);
            PG8_WAIT_V(8); PG8_WAIT_L(0); PG8_BAR; PG8_MMA(0, 0, At, B0); PG8_MMA(0, 1, At, B1); PG8_BAR; PG8_SCHED;
            PG8_LDA(At, 1, 1); PG8_STAGE(PG8_SB(1, 0), b3, voffB); PG8_STAGE(PG8_SB(1, 1), b3 + hstepB, voffB); PG8_STAGE(PG8_SA(1, 0), a3, voffA);
            PG8_WAIT_V(8); PG8_WAIT_L(0); PG8_BAR; PG8_MMA(1, 0, At, B0); PG8_MMA(1, 1, At, B1); PG8_BAR; PG8_SCHED;
        }
        if constexpr (ALIGN_EPI) { if (wr == 0) PG8_BAR; }
        E(acc, cur, wr, wc, fr, fq);
        if (!has_next) break;
#pragma unroll
        for (int a = 0; a < 2; ++a)
#pragma unroll
            for (int b = 0; b < 2; ++b)
#pragma unroll
                for (int m = 0; m < 4; ++m)
#pragma unroll
                    for (int n = 0; n < 2; ++n) acc[a][b][m][n] = (f32x4){0.f, 0.f, 0.f, 0.f};
        cur = nxt; cA = nA; cB = nB; ++ui;
        if constexpr (ALIGN_EPI) { if (wr == 1) PG8_BAR; }
    }
    PG8_WAIT_V(0);
    if constexpr (!ALIGN_EPI) { if (wr == 0) PG8_BAR; }
    PG8_BAR;
#undef PG8_SA
#undef PG8_SB
#undef PG8_STAGE
#undef PG8_LDA
#undef PG8_LDB
#undef PG8_MMA
#undef PG8_WAIT_V
#undef PG8_WAIT_L
#undef PG8_BAR
#undef PG8_SCHED
}

#define EPI_LOOP_ROWS for (int ai = 0; ai < 2; ++ai) for (int m = 0; m < 4; ++m)
struct EpiU {
    static constexpr bool PERM = true;
    bf16_t* U; const float* rs; bf16_t* HB;
    __device__ __forceinline__ void operator()(const f32x4 (&acc)[2][2][4][2], const Unit& u, int wr, int wc, int fr, int fq) const {
        const int row0 = u.pm * BM + wr * 64 + fr, col0 = u.pn * BM + wc * 32 + 8 * fq;
#pragma unroll
        for (int ai = 0; ai < 2; ++ai)
#pragma unroll
            for (int m = 0; m < 4; ++m) {
                const int row = row0 + ai * HALF + m * 16; const float s = rs[row]; bf16_t* rowp = U + (size_t)row * LDU + col0;
                const int r63 = m * 16 + fr;
#pragma unroll
                for (int bj = 0; bj < 2; ++bj) {
                    const f32x4 v0 = acc[ai][bj][m][0] * s, v1 = acc[ai][bj][m][1] * s;
                    u32x4 w; w.x = cvt_pk_bf16(v0[0], v0[1]); w.y = cvt_pk_bf16(v0[2], v0[3]); w.z = cvt_pk_bf16(v1[0], v1[1]); w.w = cvt_pk_bf16(v1[2], v1[3]);
                    *(u32x4*)(rowp + bj * HALF) = w;
                    const int c = col0 + bj * HALF;
                    if (c >= UC_QB && c < UC_QB + 768 && (r63 == 0 || r63 >= 62)) {
                        const int slot = r63 == 0 ? 0 : r63 - 61;
                        *(u32x4*)(HB + ((size_t)(row >> 6) * 3 + slot) * 768 + (c - UC_QB)) = w;
                    }
                }
            }
    }
};
__device__ __forceinline__ float rs_of(const float* rs, const float* ssp, int row) {
    if (!ssp) return rs[row];
    const f32x4* p = (const f32x4*)(ssp + (size_t)row * 16); const f32x4 a = p[0], b = p[1], c = p[2], d = p[3];
    return 1.f / sqrtf((((a[0] + a[1]) + (a[2] + a[3])) + ((b[0] + b[1]) + (b[2] + b[3])) + ((c[0] + c[1]) + (c[2] + c[3])) + ((d[0] + d[1]) + (d[2] + d[3]))) * (1.f / DM) + EPS);
}
struct EpiResN {
    static constexpr bool PERM = true;
    float* O; bf16_t* XB; float* ssp; const float* XP; const float* XS;
    __device__ __forceinline__ void operator()(const f32x4 (&acc)[2][2][4][2], const Unit& u, int wr, int wc, int fr, int fq) const {
        const int row0 = u.pm * BM + wr * 64 + fr, col0 = u.pn * BM + wc * 32 + 8 * fq, lane = fq * 16 + fr;
        const float* src = XP ? (u.pm < 128 ? XP : XS - (size_t)32768 * DM) : O;
#pragma unroll
        for (int ai = 0; ai < 2; ++ai) {
            f32x4 xv[4][2][2];
#pragma unroll
            for (int m = 0; m < 4; ++m)
#pragma unroll
                for (int bj = 0; bj < 2; ++bj) { const f32x4* p = (const f32x4*)(src + (size_t)(row0 + ai * HALF + m * 16) * DM + col0 + bj * HALF); xv[m][bj][0] = p[0]; xv[m][bj][1] = p[1]; }
#pragma unroll
            for (int m = 0; m < 4; ++m) {
                const int row = row0 + ai * HALF + m * 16; float ss = 0.f;
#pragma unroll
                for (int bj = 0; bj < 2; ++bj) {
                    f32x4* p = (f32x4*)(O + (size_t)row * DM + col0 + bj * HALF);
                    const f32x4 a = xv[m][bj][0] + acc[ai][bj][m][0], b = xv[m][bj][1] + acc[ai][bj][m][1];
                    p[0] = a; p[1] = b;
                    ss += ((a[0] * a[0] + a[1] * a[1]) + (a[2] * a[2] + a[3] * a[3])) + ((b[0] * b[0] + b[1] * b[1]) + (b[2] * b[2] + b[3] * b[3]));
                    u32x4 w; w.x = cvt_pk_bf16(a[0], a[1]); w.y = cvt_pk_bf16(a[2], a[3]); w.z = cvt_pk_bf16(b[0], b[1]); w.w = cvt_pk_bf16(b[2], b[3]);
                    *(u32x4*)(XB + (size_t)row * DM + col0 + bj * HALF) = w;
                }
                ss += shx(ss, 16, lane); ss += shx(ss, 32, lane);
                if (fq == 0) ssp[(size_t)row * 16 + u.pn * 4 + wc] = ss;
            }
        }
    }
};
struct EpiRes {
    static constexpr bool PERM = true;
    float* O;
    __device__ __forceinline__ void operator()(const f32x4 (&acc)[2][2][4][2], const Unit& u, int wr, int wc, int fr, int fq) const {
        const int row0 = u.pm * BM + wr * 64 + fr, col0 = u.pn * BM + wc * 32 + 8 * fq;
#pragma unroll
        for (int ai = 0; ai < 2; ++ai)
#pragma unroll
            for (int m = 0; m < 4; ++m) {
                float* rowp = O + (size_t)(row0 + ai * HALF + m * 16) * DM + col0;
#pragma unroll
                for (int bj = 0; bj < 2; ++bj) {
                    f32x4* p = (f32x4*)(rowp + bj * HALF);
                    const f32x4 a = p[0], b = p[1];
                    p[0] = a + acc[ai][bj][m][0]; p[1] = b + acc[ai][bj][m][1];
                }
            }
    }
};
struct EpiGU {
    static constexpr bool PERM = true;
    bf16_t* G; bf16_t* Up; const float* rs; const float* ssp;
    __device__ __forceinline__ void operator()(const f32x4 (&acc)[2][2][4][2], const Unit& u, int wr, int wc, int fr, int fq) const {
        const int row0 = u.pm * BM + wr * 64 + fr, col0 = u.pn * HALF + wc * 32 + 8 * fq;
#pragma unroll
        for (int ai = 0; ai < 2; ++ai)
#pragma unroll
            for (int m = 0; m < 4; ++m) {
                const int row = row0 + ai * HALF + m * 16; const float s = rs_of(rs, ssp, row);
#pragma unroll
                for (int bj = 0; bj < 2; ++bj) {
                    const f32x4 v0 = acc[ai][bj][m][0] * s, v1 = acc[ai][bj][m][1] * s;
                    u32x4 w; w.x = cvt_pk_bf16(v0[0], v0[1]); w.y = cvt_pk_bf16(v0[2], v0[3]); w.z = cvt_pk_bf16(v1[0], v1[1]); w.w = cvt_pk_bf16(v1[2], v1[3]);
                    *(u32x4*)((bj ? Up : G) + (size_t)row * DFF + col0) = w;
                }
            }
    }
};
struct EpiP {
    static constexpr bool PERM = true;
    bf16_t* P;
    __device__ __forceinline__ void operator()(const f32x4 (&acc)[2][2][4][2], const Unit& u, int wr, int wc, int fr, int fq) const {
        const int row0 = u.pm * BM + wr * 64 + fr, col0 = u.pn * BM + wc * 32 + 8 * fq;
#pragma unroll
        for (int ai = 0; ai < 2; ++ai)
#pragma unroll
            for (int m = 0; m < 4; ++m) {
                bf16_t* rowp = P + (size_t)(row0 + ai * HALF + m * 16) * DM + col0;
#pragma unroll
                for (int bj = 0; bj < 2; ++bj) {
                    const f32x4 v0 = acc[ai][bj][m][0], v1 = acc[ai][bj][m][1];
                    u32x4 w; w.x = cvt_pk_bf16(v0[0], v0[1]); w.y = cvt_pk_bf16(v0[2], v0[3]); w.z = cvt_pk_bf16(v1[0], v1[1]); w.w = cvt_pk_bf16(v1[2], v1[3]);
                    *(u32x4*)(rowp + bj * HALF) = w;
                }
            }
    }
};
struct EpiPle {
    static constexpr bool PERM = true;
    float* O; const bf16_t* P; const float* rs; const float* ssp;
    __device__ __forceinline__ void operator()(const f32x4 (&acc)[2][2][4][2], const Unit& u, int wr, int wc, int fr, int fq) const {
        const int row0 = u.pm * BM + wr * 64 + fr, col0 = u.pn * BM + wc * 32 + 8 * fq;
#pragma unroll
        for (int ai = 0; ai < 2; ++ai)
#pragma unroll
            for (int mh = 0; mh < 2; ++mh) {
                f32x4 xv[2][2][2]; u32x4 pv[2][2];
#pragma unroll
                for (int mm = 0; mm < 2; ++mm) {
                    const int row = row0 + ai * HALF + (2 * mh + mm) * 16;
#pragma unroll
                    for (int bj = 0; bj < 2; ++bj) { const f32x4* p = (const f32x4*)(O + (size_t)row * DM + col0 + bj * HALF); xv[mm][bj][0] = p[0]; xv[mm][bj][1] = p[1];
                        pv[mm][bj] = *(const u32x4*)(P + (size_t)row * DM + col0 + bj * HALF); }
                }
#pragma unroll
                for (int mm = 0; mm < 2; ++mm) {
                    const int m = 2 * mh + mm, row = row0 + ai * HALF + m * 16; const float s = rs_of(rs, ssp, row);
#pragma unroll
                    for (int bj = 0; bj < 2; ++bj) {
                        f32x4* p = (f32x4*)(O + (size_t)row * DM + col0 + bj * HALF);
                        const u32x4 pw = pv[mm][bj];
                        f32x4 a = xv[mm][bj][0], b = xv[mm][bj][1];
                        const f32x4 g0 = acc[ai][bj][m][0] * s, g1 = acc[ai][bj][m][1] * s;
                        a[0] += sigmoidf_(g0[0]) * bflo(pw.x); a[1] += sigmoidf_(g0[1]) * bfhi(pw.x); a[2] += sigmoidf_(g0[2]) * bflo(pw.y); a[3] += sigmoidf_(g0[3]) * bfhi(pw.y);
                        b[0] += sigmoidf_(g1[0]) * bflo(pw.z); b[1] += sigmoidf_(g1[1]) * bfhi(pw.z); b[2] += sigmoidf_(g1[2]) * bflo(pw.w); b[3] += sigmoidf_(g1[3]) * bfhi(pw.w);
                        p[0] = a; p[1] = b;
                    }
                }
            }
    }
};
}
struct Args { const float* in[32]; float* out; unsigned char* ws; };
typedef const __attribute__((address_space(4))) Args* KArgs;
__device__ __forceinline__ KArgs kargs() { KArgs p = (KArgs)__builtin_amdgcn_kernarg_segment_ptr(); asm volatile("" : "+s"(p)); return p; }
__device__ __forceinline__ int tidx(int wv) { unsigned z = 0u; asm volatile("" : "+s"(wv), "+s"(z)); int t = wv * 64 + (int)__builtin_amdgcn_mbcnt_hi(~0u, __builtin_amdgcn_mbcnt_lo(~0u, z)); asm volatile("" : "+v"(t)); return t; }
__device__ __forceinline__ int bidx() { int t = blockIdx.x; asm volatile("" : "+s"(t)); return t; }
__device__ __forceinline__ int gdim() { int t = gridDim.x; asm volatile("" : "+s"(t)); return t; }
enum { I_XP = 0, I_XS, I_PP, I_PS, I_N1, I_N2, I_N3, I_WIN, I_WOUT, I_CAW, I_CAB, I_LWR, I_LBR, I_LWI, I_LBI, I_LLAM, I_GCONV, I_GALOG, I_GDT, I_GNORM,
       I_RDEC, I_RNORM, I_QN, I_KN, I_RPB, I_WG, I_WU, I_FCW, I_FCB, I_WD, I_PPROJ, I_PGATE };
constexpr int LDS_BYTES = 147456;
#define GSYNC_CG() do { cg::this_grid().sync(); } while (0)
__device__ __forceinline__ void grid_bar(unsigned target) {
    __syncthreads();
    if (threadIdx.x == 0) {
        unsigned* ctr = (unsigned*)(kargs()->ws + WS_BAR);
        __builtin_amdgcn_fence(__ATOMIC_RELEASE, "agent");
        (void)__hip_atomic_fetch_add(ctr, 1u, __ATOMIC_RELAXED, __HIP_MEMORY_SCOPE_AGENT);
        while (__hip_atomic_load(ctr, __ATOMIC_RELAXED, __HIP_MEMORY_SCOPE_AGENT) < target) __builtin_amdgcn_s_sleep(2);
        __builtin_amdgcn_fence(__ATOMIC_ACQUIRE, "agent");
    }
    __syncthreads();
}
#define GSYNC() do { nbar += gridDim.x; grid_bar(nbar); } while (0)

__device__ __forceinline__ void tr_item(const float* __restrict__ W, int N, const float* __restrict__ gain, bf16_t* WT, int K, int k0, int src_n0, int dst_n0, float* scr, int lane) {
#pragma unroll 8
    for (int i = 0; i < 32; ++i) { const int kk = 2 * i + (lane >> 5); const float g = gain ? gain[k0 + kk] : 1.f;
        scr[kk * 33 + (lane & 31)] = W[(size_t)(k0 + kk) * N + src_n0 + (lane & 31)] * g; }
    LDSW();
    const int c = lane & 7;
#pragma unroll
    for (int j = 0; j < 4; ++j) { const int n = (lane >> 3) + 8 * j; const float* s = scr + (8 * c) * 33 + n;
        u32x4 o; o.x = pk2(s[0 * 33], s[1 * 33]); o.y = pk2(s[2 * 33], s[3 * 33]); o.z = pk2(s[4 * 33], s[5 * 33]); o.w = pk2(s[6 * 33], s[7 * 33]);
        *(u32x4*)(WT + (size_t)(dst_n0 + n) * K + k0 + 8 * c) = o; }
    LDSW();
}
__device__ __forceinline__ int win_src(int d) {
    if (d < 256) return 256 + d;
    if (d < 512) return 1280 + (d - 256);
    if (d < 768) return 2320 + (d - 512);
    if (d < 1024) return 2576 + (d - 768);
    if (d < 1280) return d - 1024;
    if (d < 2048) return 512 + (d - 1280);
    if (d < 2816) return 1552 + (d - 2048);
    return 2832 + (d - 2816);
}
__device__ __forceinline__ void phase_weights(int wv, int l, int which, int b0 = 0) {
    asm volatile("" : "+s"(l));
    unsigned char* lds = lds_dyn;
    KArgs a = kargs();
    const int tid_ = tidx(wv), bid_ = bidx(), gd_ = gdim();
    const int lane = tid_ & 63, wave = tid_ >> 6;
    float* scr = (float*)lds + 65536 / 4 + wave * (64 * 33);
    if (bid_ < b0) return;
    const int gw = (bid_ - b0) * 8 + wave, NGW = (gd_ - b0) * 8;
    unsigned char* ws = a->ws;
    constexpr int nWin = 16 * 104, nWout = 16 * 32, nWgu = 16 * 176, nWd = 44 * 32, nWpg = 16 * 32, nWpp = 4 * 32;
    if (which & 1) {
        for (int it = gw; it < nWin + nWout; it += NGW) {
            int r = it;
            if (r < nWin) { const int kb = r / 104, nb = r % 104; tr_item(a->in[I_WIN] + (size_t)l * DM * INC, INC, a->in[I_N1] + l * DM, (bf16_t*)(ws + WS_WIN), DM, kb * 64, win_src(nb * 32), nb * 32, scr, lane); continue; }
            r -= nWin;
            { const int kb = r / 32, nb = r % 32; tr_item(a->in[I_WOUT] + (size_t)l * DM * DM, DM, nullptr, (bf16_t*)(ws + WS_WOUT), DM, kb * 64, nb * 32, nb * 32, scr, lane); }
        }
        bf16_t* wl = (bf16_t*)(ws + WS_LRU);
        for (int i = (bid_ - b0) * 512 + tid_; i < 65536; i += (gd_ - b0) * 512) {
            const int k = i & 63, n = (i >> 6) & 63, h = (i >> 12) & 3, ty = (i >> 14) & 1, dir = i >> 15;
            const float* src = a->in[ty ? I_LWI : I_LWR] + (size_t)l * 32768 + (size_t)(dir * 4 + h) * 4096;
            wl[i] = (bf16_t)f2bf(src[k * 64 + n]);
        }
    }
    if (which & 2) {
        for (int it = gw; it < nWgu + nWd + nWpg + nWpp; it += NGW) {
            int r = it;
            if (r < nWgu) { const int kb = r / 176, nb = r % 176, d0 = nb * 32, pn = d0 >> 8, w = d0 & 255;
                tr_item(a->in[w < 128 ? I_WG : I_WU] + (size_t)l * DM * DFF, DFF, a->in[I_N2] + l * DM, (bf16_t*)(ws + WS_WGU), DM, kb * 64, pn * 128 + (w & 127), d0, scr, lane); continue; }
            r -= nWgu;
            if (r < nWd) { const int kb = r / 32, nb = r % 32; tr_item(a->in[I_WD] + (size_t)l * DFF * DM, DM, nullptr, (bf16_t*)(ws + WS_WD), DFF, kb * 64, nb * 32, nb * 32, scr, lane); continue; }
            r -= nWd;
            if (r < nWpg) { const int kb = r / 32, nb = r % 32; tr_item(a->in[I_PGATE] + (size_t)l * DM * DM, DM, a->in[I_N3] + l * DM, (bf16_t*)(ws + WS_WPG), DM, kb * 64, nb * 32, nb * 32, scr, lane); continue; }
            r -= nWpg;
            { const int kb = r / 32, nb = r % 32; tr_item(a->in[I_PPROJ] + (size_t)l * PLED * DM, DM, nullptr, (bf16_t*)(ws + WS_WPP), PLED, kb * 64, nb * 32, nb * 32, scr, lane); }
        }
    }
}

__device__ __forceinline__ void phase_norm(int wv, int l, int mode) {
    asm volatile("" : "+s"(l));
    unsigned char* lds = lds_dyn;
    KArgs a = kargs();
    const int tid_ = tidx(wv), bid_ = bidx(), gd_ = gdim();
    const int lane = tid_ & 63, wave = tid_ >> 6;
    const int gw = bid_ * 8 + wave, NGW = gd_ * 8;
    float* Wba = (float*)lds;
    if (mode & 2) {
        const float* win = a->in[I_WIN] + (size_t)l * DM * INC; const float* g1 = a->in[I_N1] + l * DM;
        for (int i = tid_; i < 16384; i += 512) { const int j = i & 15, k = i >> 4; Wba[j * 1024 + k] = win[(size_t)k * INC + 1536 + j] * g1[k]; }
        __syncthreads();
    }
    bf16_t* xb = (bf16_t*)(a->ws + WS_XB); float* rs = (float*)(a->ws + WS_RS); float* ba = (float*)(a->ws + WS_BA);
    for (int m = gw; m < M_TOK; m += NGW) {
        const float* xrow = (mode & 1) ? (m < 32768 ? a->in[I_XP] + (size_t)m * DM : a->in[I_XS] + (size_t)(m - 32768) * DM) : a->out + (size_t)m * DM;
        const f32x4* xr = (const f32x4*)xrow + lane;
        f32x4 v[4]; float s = 0.f;
#pragma unroll
        for (int j = 0; j < 4; ++j) { v[j] = xr[64 * j]; s += (v[j].x * v[j].x + v[j].y * v[j].y) + (v[j].z * v[j].z + v[j].w * v[j].w); }
        const float r = 1.f / sqrtf(wave_sum(s, lane) * (1.f / DM) + EPS);
        u32x2* o8 = (u32x2*)(xb + (size_t)m * DM) + lane;
#pragma unroll
        for (int j = 0; j < 4; ++j) { u32x2 w; w.x = pk2(v[j].x, v[j].y); w.y = pk2(v[j].z, v[j].w); o8[64 * j] = w; }
        if (lane == 0) rs[m] = r;
        if (mode & 2) {
            float mine = 0.f;
#pragma unroll 1
            for (int o = 0; o < 16; ++o) {
                float d = 0.f;
#pragma unroll
                for (int j = 0; j < 4; ++j) { const f32x4 w = *(const f32x4*)(Wba + o * 1024 + 256 * j + 4 * lane); d += (v[j].x * w.x + v[j].y * w.y) + (v[j].z * w.z + v[j].w * w.w); }
                d = wave_sum(d, lane);
                if (lane == o) mine = d;
            }
            if (lane < 16) ba[(size_t)m * 16 + lane] = mine * r;
        }
    }
}

__device__ __forceinline__ void phase_ffn_elem(int wv, int l, int row0) {
    asm volatile("" : "+s"(l));
    KArgs a = kargs();
    const int tid_ = tidx(wv), bid_ = bidx(), gd_ = gdim();
    const bf16_t* G = (const bf16_t*)(a->ws + WS_G); bf16_t* Up = (bf16_t*)(a->ws + WS_UP);
    const float* cw = a->in[I_FCW] + (size_t)l * 3 * DFF; const float* cb = a->in[I_FCB] + (size_t)l * DFF;
    constexpr int C8 = DFF / 8, RSEG = 32, NSEG = MH / RSEG;
    for (int idx = bid_ * 512 + tid_; idx < NSEG * C8; idx += gd_ * 512) {
        const int c = (idx % C8) * 8, r0 = (idx / C8) * RSEG;
        float w0[8], w1[8], w2[8], bb[8];
#pragma unroll
        for (int h4 = 0; h4 < 2; ++h4) { const f32x4 x0 = *(const f32x4*)(cw + c + 4 * h4), x1 = *(const f32x4*)(cw + DFF + c + 4 * h4), x2 = *(const f32x4*)(cw + 2 * DFF + c + 4 * h4), x3 = *(const f32x4*)(cb + c + 4 * h4);
#pragma unroll
            for (int e = 0; e < 4; ++e) { w0[4 * h4 + e] = x0[e]; w1[4 * h4 + e] = x1[e]; w2[4 * h4 + e] = x2[e]; bb[4 * h4 + e] = x3[e]; } }
        const u32x4 z = {0u, 0u, 0u, 0u};
        const int t0 = row0 + r0;
        u32x4 gm = (t0 == seq_start_tok(t0)) ? z : *(const u32x4*)(G + (size_t)(r0 - 1) * DFF + c);
        u32x4 g0 = *(const u32x4*)(G + (size_t)r0 * DFF + c);
#pragma unroll 4
        for (int rr = 0; rr < RSEG; ++rr) {
            const int rl = r0 + rr, t = row0 + rl;
            const u32x4 gp = (t + 1 == seq_end_tok(t)) ? z : *(const u32x4*)(G + (size_t)(rl + 1) * DFF + c);
            const u32x4 up = *(const u32x4*)(Up + (size_t)rl * DFF + c);
            float o[8];
#pragma unroll
            for (int j = 0; j < 4; ++j) {
                const float ga = w0[2 * j] * bflo(gm[j]) + w1[2 * j] * bflo(g0[j]) + w2[2 * j] * bflo(gp[j]) + bb[2 * j];
                const float gb = w0[2 * j + 1] * bfhi(gm[j]) + w1[2 * j + 1] * bfhi(g0[j]) + w2[2 * j + 1] * bfhi(gp[j]) + bb[2 * j + 1];
                o[2 * j] = gelu_tanh(ga) * bflo(up[j]); o[2 * j + 1] = gelu_tanh(gb) * bfhi(up[j]);
            }
            u32x4 w; w.x = pk2(o[0], o[1]); w.y = pk2(o[2], o[3]); w.z = pk2(o[4], o[5]); w.w = pk2(o[6], o[7]);
            *(u32x4*)(Up + (size_t)rl * DFF + c) = w;
            gm = g0; g0 = gp;
        }
    }
}
__device__ __forceinline__ void phase_pconv(int wv, int l) {
    asm volatile("" : "+s"(l));
    KArgs a = kargs();
    const int tid_ = tidx(wv), bid_ = bidx(), gd_ = gdim();
    bf16_t* pb = (bf16_t*)(a->ws + WS_PB);
    const float* pp = a->in[I_PP] + (size_t)l * 32768 * PLED; const float* ps = a->in[I_PS] + (size_t)l * 16384 * PLED;
    for (int idx = bid_ * 512 + tid_; idx < M_TOK * PLED / 4; idx += gd_ * 512) {
        const size_t e = (size_t)idx * 4;
        const f32x4 v = e < (size_t)32768 * PLED ? *(const f32x4*)(pp + e) : *(const f32x4*)(ps + (e - (size_t)32768 * PLED));
        u32x2 w; w.x = pk2(v.x, v.y); w.y = pk2(v.z, v.w);
        *(u32x2*)(pb + e) = w;
    }
}
__device__ __forceinline__ int chunk_seq_c0(int gc) { return gc < 512 ? (gc & ~127) : 512; }
__device__ __forceinline__ int chunk_seq_n(int gc) { return gc < 512 ? 128 : 256; }
__device__ __forceinline__ void unpack8(const u32x4 w, float* f) {
    f[0] = bflo(w.x); f[1] = bfhi(w.x); f[2] = bflo(w.y); f[3] = bfhi(w.y); f[4] = bflo(w.z); f[5] = bfhi(w.z); f[6] = bflo(w.w); f[7] = bfhi(w.w);
}
__device__ __forceinline__ u32x4 pack8(const float* f) { u32x4 w; w.x = pk2(f[0], f[1]); w.y = pk2(f[2], f[3]); w.z = pk2(f[4], f[5]); w.w = pk2(f[6], f[7]); return w; }

#define RAW_BAR() do { asm volatile("s_waitcnt lgkmcnt(0)" ::: "memory"); __builtin_amdgcn_s_barrier(); asm volatile("" ::: "memory"); } while (0)

__device__ __forceinline__ void mixD_job(KArgs a, int l, int gc, int h, int tid, bool dry) {
    asm volatile("" : "+s"(l));
    unsigned char* lds = lds_dyn;
    asm volatile("" : "+v"(tid));
    bf16_t* U = (bf16_t*)(a->ws + WS_U);
    bf16_t* Kn = (bf16_t*)lds;
    bf16_t* Vt = (bf16_t*)(lds + 65536);
    bf16_t* Qs = (bf16_t*)(lds + 65536 + 66560);
    float* Rp = (float*)(lds + 65536 + 66560 + 9216);
    const int lane = tid & 63, wave = tid >> 6;
    const int c0s = chunk_seq_c0(gc), rows = chunk_seq_n(gc), r = gc - c0s;
    int r0 = r - 4; r0 = r0 < 0 ? 0 : (r0 > rows - 8 ? rows - 8 : r0);
    {
        const int ch = tid & 7, kq = tid >> 3;
        const float* gk = a->in[I_KN] + l * 64 + ch * 8; const float* gq = a->in[I_QN] + l * 64 + ch * 8;
        u32x4 kw[8], vw[8];
#pragma unroll
        for (int it = 0; it < 8; ++it) { const int key = it * 64 + kq; const size_t tok = (size_t)(c0s + r0 + (key >> 6)) * 64 + (key & 63);
            kw[it] = *(const u32x4*)(U + tok * LDU + UC_KD + h * 64 + ch * 8); vw[it] = *(const u32x4*)(U + tok * LDU + UC_VD + h * 64 + ch * 8); }
        const u32x4 qw = *(const u32x4*)(U + ((size_t)gc * 64 + kq) * LDU + UC_QD + h * 64 + ch * 8);
        float gkf[8], gqf[8];
#pragma unroll
        for (int j = 0; j < 8; ++j) { gkf[j] = gk[j]; gqf[j] = gq[j]; }
        const float* rpb = a->in[I_RPB] + (size_t)(l * 4 + h) * 465;
        if (tid < 465) Rp[tid] = rpb[tid];
#pragma unroll
        for (int it = 0; it < 8; ++it) { const int key = it * 64 + kq;
            float f[8]; unpack8(kw[it], f); float ss = 0.f;
#pragma unroll
            for (int j = 0; j < 8; ++j) ss += f[j] * f[j];
            ss += shx(ss, 1, tid); ss += shx(ss, 2, tid); ss += shx(ss, 4, tid);
            const float inv = 1.f / sqrtf(ss * (1.f / 64.f) + EPS);
#pragma unroll
            for (int j = 0; j < 8; ++j) f[j] = f[j] * inv * gkf[j];
            *(u32x4*)(Kn + key * 64 + ((ch ^ (key & 7)) << 3)) = pack8(f);
            const unsigned ww[4] = {vw[it].x, vw[it].y, vw[it].z, vw[it].w};
#pragma unroll
            for (int j = 0; j < 4; ++j) { Vt[(ch * 8 + 2 * j) * 520 + key] = (bf16_t)(ww[j] & 0xffffu); Vt[(ch * 8 + 2 * j + 1) * 520 + key] = (bf16_t)(ww[j] >> 16); } }
        {   float f[8]; unpack8(qw, f); float s2 = 0.f;
#pragma unroll
            for (int j = 0; j < 8; ++j) s2 += f[j] * f[j];
            s2 += shx(s2, 1, tid); s2 += shx(s2, 2, tid); s2 += shx(s2, 4, tid);
            const float qi = 0.125f / sqrtf(s2 * (1.f / 64.f) + EPS);
#pragma unroll
            for (int j = 0; j < 8; ++j) f[j] = f[j] * qi * gqf[j];
            *(u32x4*)(Qs + kq * 72 + ch * 8) = pack8(f); }
    }
    RAW_BAR();
    const int g = wave & 3, c = lane & 15, q = lane >> 4;
    const int cstart = g == 0 ? 0 : (g == 1 ? 8 : (g == 2 ? 24 : 32));
    f32x4 sc[16];
    if (wave < 4) {
        const bf16x8 qa0 = *(const bf16x8*)(Qs + (16 * g + c) * 72 + 8 * q), qa1 = *(const bf16x8*)(Qs + (16 * g + c) * 72 + 32 + 8 * q);
#pragma unroll
        for (int tt = 0; tt < 16; ++tt) {
            const int key = (tt >> 1) * 64 + cstart + (tt & 1) * 16 + c;
            const bf16x8 b0 = *(const bf16x8*)(Kn + key * 64 + ((q ^ (key & 7)) << 3)), b1 = *(const bf16x8*)(Kn + key * 64 + (((4 + q) ^ (key & 7)) << 3));
            f32x4 z = {0.f, 0.f, 0.f, 0.f};
            z = mfma16(qa0, b0, z); sc[tt] = mfma16(qa1, b1, z);
        }
    }
    RAW_BAR();
    if (wave < 4) {
        bf16_t* Pst = Kn + wave * (16 * 264);
        float mx[4] = {-1e30f, -1e30f, -1e30f, -1e30f};
#pragma unroll
        for (int tt = 0; tt < 16; ++tt) {
            const int kr = tt >> 1, kc = cstart + (tt & 1) * 16 + c; const int dr = r0 + kr - r + 7;
#pragma unroll
            for (int j = 0; j < 4; ++j) {
                const int qc = 16 * g + 4 * q + j; int c0 = qc - 8; c0 = c0 < 0 ? 0 : (c0 > 48 ? 48 : c0);
                const bool ok = (kc >= c0) && (kc < c0 + 16);
                const float s = ok ? sc[tt][j] + Rp[dr * 31 + (kc - qc + 15)] : -1e30f;
                sc[tt][j] = s; mx[j] = fmaxf(mx[j], s);
            }
        }
        float sum[4];
#pragma unroll
        for (int j = 0; j < 4; ++j) { float m = mx[j]; m = fmaxf(m, shx(m, 1, tid)); m = fmaxf(m, shx(m, 2, tid)); m = fmaxf(m, shx(m, 4, tid)); m = fmaxf(m, shx(m, 8, tid)); mx[j] = m; sum[j] = 0.f; }
#pragma unroll
        for (int tt = 0; tt < 16; ++tt)
#pragma unroll
            for (int j = 0; j < 4; ++j) { const float p = sc[tt][j] > -1e29f ? __expf(sc[tt][j] - mx[j]) : 0.f; sum[j] += p; Pst[(4 * q + j) * 264 + tt * 16 + c] = (bf16_t)f2bf(p); }
#pragma unroll
        for (int j = 0; j < 4; ++j) { float s = sum[j]; s += shx(s, 1, tid); s += shx(s, 2, tid); s += shx(s, 4, tid); s += shx(s, 8, tid); sum[j] = 1.f / s; }
        LDSW();
        f32x4 o[4];
#pragma unroll
        for (int dt = 0; dt < 4; ++dt) o[dt] = (f32x4){0.f, 0.f, 0.f, 0.f};
#pragma unroll
        for (int kb = 0; kb < 8; ++kb) {
            const bf16x8 pa = *(const bf16x8*)(Pst + c * 264 + kb * 32 + 8 * q);
#pragma unroll
            for (int dt = 0; dt < 4; ++dt) { const bf16x8 vb = *(const bf16x8*)(Vt + (16 * dt + c) * 520 + kb * 64 + cstart + 8 * q); o[dt] = mfma16(pa, vb, o[dt]); }
        }
#pragma unroll
        for (int dt = 0; dt < 4; ++dt)
#pragma unroll
            for (int j = 0; j < 4; ++j) if (!dry) U[((size_t)gc * 64 + 16 * g + 4 * q + j) * LDU + UC_QD + h * 64 + 16 * dt + c] = (bf16_t)f2bf(o[dt][j] * sum[j]);
    }
    RAW_BAR();
}
__device__ __forceinline__ void mixC_local(KArgs a, int l, int gc, int h, int tid, bool dry) {
    asm volatile("" : "+s"(l));
    unsigned char* lds = lds_dyn;
    asm volatile("" : "+v"(tid));
    bf16_t* U = (bf16_t*)(a->ws + WS_U);
    bf16_t* Qh = (bf16_t*)lds; bf16_t* Kh = Qh + 64 * 72; bf16_t* Vt = Kh + 64 * 72; bf16_t* KfT = Vt + 64 * 72; bf16_t* KbT = KfT + 64 * 72; bf16_t* Ph = KbT + 64 * 72;
    const int lane = tid & 63, wave = tid >> 6;
    const int c0s = chunk_seq_c0(gc);
    const float lgf = log1p_small(-__builtin_amdgcn_exp2f(-a->in[I_RDEC][l * 8 + h])), lgb = log1p_small(-__builtin_amdgcn_exp2f(-a->in[I_RDEC][l * 8 + 4 + h]));
    const size_t t0 = (size_t)gc * 64;
    const int row = tid >> 3, ch = tid & 7;
    bf16_t* urow8 = U + (t0 + row) * LDU + h * 64 + ch * 8;
    {
        const u32x4 qw = *(const u32x4*)(urow8 + UC_QC), kw = *(const u32x4*)(urow8 + UC_KC), vw = *(const u32x4*)(urow8 + UC_VC);
        *(u32x4*)(Qh + row * 72 + ch * 8) = qw; *(u32x4*)(Kh + row * 72 + ch * 8) = kw;
        const unsigned ww[4] = {vw.x, vw.y, vw.z, vw.w};
#pragma unroll
        for (int j = 0; j < 4; ++j) { Vt[(ch * 8 + 2 * j) * 72 + row] = (bf16_t)(ww[j] & 0xffffu); Vt[(ch * 8 + 2 * j + 1) * 72 + row] = (bf16_t)(ww[j] >> 16); }
    }
    RAW_BAR();
    {
        const int p = tid & 31;
        const float inv = powf(10000.f, -(float)p * (1.f / 32.f));
#pragma unroll 1
        for (int i = tid >> 5; i < 64; i += 16) {
            const float pos = (float)((gc - c0s) * 64 + i);
            float sn, cs; sincosf(pos * inv, &sn, &cs);
            const float q1 = bf2f(Qh[i * 72 + p]), q2 = bf2f(Qh[i * 72 + p + 32]), k1 = bf2f(Kh[i * 72 + p]) * 0.125f, k2 = bf2f(Kh[i * 72 + p + 32]) * 0.125f;
            const float qa = q1 * cs - q2 * sn, qb = q1 * sn + q2 * cs, ka = k1 * cs - k2 * sn, kb = k1 * sn + k2 * cs;
            Qh[i * 72 + p] = (bf16_t)f2bf(qa); Qh[i * 72 + p + 32] = (bf16_t)f2bf(qb);
            Kh[i * 72 + p] = (bf16_t)f2bf(ka); Kh[i * 72 + p + 32] = (bf16_t)f2bf(kb);
            const float df = __expf((float)(63 - i) * lgf), db = __expf((float)i * lgb);
            KfT[p * 72 + i] = (bf16_t)f2bf(ka * df); KfT[(p + 32) * 72 + i] = (bf16_t)f2bf(kb * df);
            KbT[p * 72 + i] = (bf16_t)f2bf(ka * db); KbT[(p + 32) * 72 + i] = (bf16_t)f2bf(kb * db);
        }
    }
    RAW_BAR();
    if (!dry) *(u32x4*)(urow8 + UC_QC) = *(const u32x4*)(Qh + row * 72 + ch * 8);
    const int c = lane & 15, q = lane >> 4;
    bf16_t* KV = (bf16_t*)(a->ws + WS_KV);
#pragma unroll
    for (int s = 0; s < 2; ++s) {
        const int tile = 2 * wave + s, rt = tile >> 2, ct = tile & 3;
        {
            f32x4 z = {0.f, 0.f, 0.f, 0.f};
#pragma unroll
            for (int kb = 0; kb < 2; ++kb) z = mfma16(*(const bf16x8*)(Qh + (16 * rt + c) * 72 + kb * 32 + 8 * q), *(const bf16x8*)(Kh + (16 * ct + c) * 72 + kb * 32 + 8 * q), z);
#pragma unroll
            for (int j = 0; j < 4; ++j) { const int i = 16 * rt + 4 * q + j, jj = 16 * ct + c;
                const float dm = jj < i ? __expf((float)(i - jj) * lgf) : (jj > i ? __expf((float)(jj - i) * lgb) : 2.f);
                Ph[i * 72 + jj] = (bf16_t)f2bf(z[j] * dm); }
        }
#pragma unroll
        for (int dir = 0; dir < 2; ++dir) {
            const bf16_t* KT = dir ? KbT : KfT;
            f32x4 z = {0.f, 0.f, 0.f, 0.f};
#pragma unroll
            for (int kb = 0; kb < 2; ++kb) z = mfma16(*(const bf16x8*)(KT + (16 * rt + c) * 72 + kb * 32 + 8 * q), *(const bf16x8*)(Vt + (16 * ct + c) * 72 + kb * 32 + 8 * q), z);
            u32x2 w; w.x = pk2(z[0], z[1]); w.y = pk2(z[2], z[3]);
            if (!dry) *(u32x2*)(KV + ((size_t)(gc * 4 + h) * 2 + dir) * 4096 + (16 * ct + c) * 64 + 16 * rt + 4 * q) = w;
        }
    }
    RAW_BAR();
#pragma unroll
    for (int s = 0; s < 2; ++s) {
        const int tile = 2 * wave + s, rt = tile >> 2, ct = tile & 3;
        f32x4 z = {0.f, 0.f, 0.f, 0.f};
#pragma unroll
        for (int kb = 0; kb < 2; ++kb) z = mfma16(*(const bf16x8*)(Ph + (16 * rt + c) * 72 + kb * 32 + 8 * q), *(const bf16x8*)(Vt + (16 * ct + c) * 72 + kb * 32 + 8 * q), z);
#pragma unroll
        for (int j = 0; j < 4; ++j) if (!dry) U[(t0 + 16 * rt + 4 * q + j) * LDU + UC_VC + h * 64 + 16 * ct + c] = (bf16_t)f2bf(z[j]);
    }
    RAW_BAR();
}
__device__ __forceinline__ void mixC_scan(KArgs a, int l, int job, int tid, bool dry) {
    asm volatile("" : "+s"(l));
    asm volatile("" : "+v"(tid));
    const int quarter = job & 3, dir = (job >> 2) & 1, h = (job >> 3) & 3, s = job >> 5;
    const int c0 = s < 4 ? 128 * s : 512, n = s < 4 ? 128 : 256;
    const float lg = log1p_small(-__builtin_amdgcn_exp2f(-a->in[I_RDEC][l * 8 + dir * 4 + h]));
    const float D = __expf(64.f * lg);
    unsigned* KV = (unsigned*)(a->ws + WS_KV) + quarter * 512 + tid;
    float s0 = 0.f, s1 = 0.f;
    for (int nb = 0; nb < n; nb += 16) {
        unsigned w[16];
#pragma unroll
        for (int j = 0; j < 16; ++j) { const int gc = dir ? c0 + n - 1 - (nb + j) : c0 + nb + j; w[j] = KV[((size_t)(gc * 4 + h) * 2 + dir) * 2048]; }
#pragma unroll
        for (int j = 0; j < 16; ++j) { const int gc = dir ? c0 + n - 1 - (nb + j) : c0 + nb + j;
            if (!dry) KV[((size_t)(gc * 4 + h) * 2 + dir) * 2048] = pk2(s0, s1);
            s0 = s0 * D + bflo(w[j]); s1 = s1 * D + bfhi(w[j]); }
    }
}
__device__ __forceinline__ void mixC_final(KArgs a, int l, int gc, int h, int tid, bool dry) {
    asm volatile("" : "+s"(l));
    unsigned char* lds = lds_dyn;
    asm volatile("" : "+v"(tid));
    bf16_t* U = (bf16_t*)(a->ws + WS_U);
    bf16_t* Qf = (bf16_t*)lds; bf16_t* Qb = Qf + 64 * 72; float* Of = (float*)(lds + 2 * 64 * 72 * 2);
    const int lane = tid & 63, wave = tid >> 6;
    const float lgf = log1p_small(-__builtin_amdgcn_exp2f(-a->in[I_RDEC][l * 8 + h])), lgb = log1p_small(-__builtin_amdgcn_exp2f(-a->in[I_RDEC][l * 8 + 4 + h]));
    const size_t t0 = (size_t)gc * 64;
    const int row = tid >> 3, e0 = (tid & 7) * 8;
    bf16_t* urow8 = U + (t0 + row) * LDU + h * 64 + e0;
    const u32x4 qw = *(const u32x4*)(urow8 + UC_QC), iw = *(const u32x4*)(urow8 + UC_VC), gw = *(const u32x4*)(urow8 + UC_GC);
    const int c = lane & 15, q = lane >> 4;
    const bf16_t* KV = (const bf16_t*)(a->ws + WS_KV) + (size_t)(gc * 4 + h) * 2 * 4096;
    bf16x8 kvf[2][2], kvb[2][2];
#pragma unroll
    for (int s = 0; s < 2; ++s) { const int ct = (2 * wave + s) & 3;
#pragma unroll
        for (int kb = 0; kb < 2; ++kb) { kvf[s][kb] = *(const bf16x8*)(KV + (16 * ct + c) * 64 + kb * 32 + 8 * q); kvb[s][kb] = *(const bf16x8*)(KV + 4096 + (16 * ct + c) * 64 + kb * 32 + 8 * q); } }
    {
        float f[8], o[8]; unpack8(qw, f);
        const float ef = __expf((float)(row + 1) * lgf), eb = __expf((float)(64 - row) * lgb);
#pragma unroll
        for (int j = 0; j < 8; ++j) o[j] = f[j] * ef;
        *(u32x4*)(Qf + row * 72 + e0) = pack8(o);
#pragma unroll
        for (int j = 0; j < 8; ++j) o[j] = f[j] * eb;
        *(u32x4*)(Qb + row * 72 + e0) = pack8(o);
        unpack8(iw, f);
#pragma unroll
        for (int j = 0; j < 8; ++j) Of[row * 65 + e0 + j] = f[j];
    }
    RAW_BAR();
#pragma unroll
    for (int s = 0; s < 2; ++s) {
        const int tile = 2 * wave + s, rt = tile >> 2, ct = tile & 3;
        f32x4 z = {0.f, 0.f, 0.f, 0.f};
#pragma unroll
        for (int kb = 0; kb < 2; ++kb) {
            z = mfma16(*(const bf16x8*)(Qf + (16 * rt + c) * 72 + kb * 32 + 8 * q), kvf[s][kb], z);
            z = mfma16(*(const bf16x8*)(Qb + (16 * rt + c) * 72 + kb * 32 + 8 * q), kvb[s][kb], z);
        }
#pragma unroll
        for (int j = 0; j < 4; ++j) Of[(16 * rt + 4 * q + j) * 65 + 16 * ct + c] += z[j];
    }
    RAW_BAR();
    {
        const float* gn = a->in[I_RNORM] + l * 64;
        float v[8], s1 = 0.f;
#pragma unroll
        for (int j = 0; j < 8; ++j) { v[j] = Of[row * 65 + e0 + j]; s1 += v[j]; }
        s1 += shx(s1, 1, tid); s1 += shx(s1, 2, tid); s1 += shx(s1, 4, tid);
        const float mu = s1 * (1.f / 64.f); float s2 = 0.f;
#pragma unroll
        for (int j = 0; j < 8; ++j) { v[j] -= mu; s2 += v[j] * v[j]; }
        s2 += shx(s2, 1, tid); s2 += shx(s2, 2, tid); s2 += shx(s2, 4, tid);
        const float rstd = 1.f / sqrtf(s2 * (1.f / 64.f) + EPS);
        float g[8]; unpack8(gw, g);
#pragma unroll
        for (int j = 0; j < 8; ++j) v[j] = v[j] * rstd * gn[e0 + j] * siluf_(g[j]);
        if (!dry) *(u32x4*)(urow8 + UC_GC) = pack8(v);
    }
    RAW_BAR();
}

__device__ __forceinline__ void mixA_job(KArgs a, int l, int gc, int h, int pass, int tid, bool dry) {
    asm volatile("" : "+s"(l));
    unsigned char* lds = lds_dyn;
    asm volatile("" : "+v"(tid));
    bf16_t* U = (bf16_t*)(a->ws + WS_U);
    float* Xc = (float*)lds;
    bf16_t* Xh = (bf16_t*)(lds + 16640);
    float* Aa = (float*)(lds + 16640 + 9216);
    float* Bb = Aa + 2 * 64 * 65;
    bf16_t* Xr = (bf16_t*)(lds + 92416);
    float* Gp = (float*)(lds + 92416 + 9648);
    const int lane = tid & 63, wave = tid >> 6;
    const int t0 = gc * 64, ts = seq_start_tok(t0), te = seq_end_tok(t0);
    const int row = tid >> 3, ch8 = (tid & 7) * 8;
    u32x4 yaw = {0u, 0u, 0u, 0u}; float carry_in = 0.f;
    {
        const u32x4 z4 = {0u, 0u, 0u, 0u};
        { const int t = t0 - 2 + row; *(u32x4*)(Xr + row * 72 + ch8) = (t >= ts && t < te) ? *(const u32x4*)(U + (size_t)t * LDU + UC_XA + h * 64 + ch8) : z4; }
        if (tid < 24) { const int rr = 64 + row, t = t0 - 2 + rr; *(u32x4*)(Xr + rr * 72 + ch8) = (t >= ts && t < te) ? *(const u32x4*)(U + (size_t)t * LDU + UC_XA + h * 64 + ch8) : z4; }
        if (pass == 2) yaw = *(const u32x4*)(U + (size_t)(t0 + row) * LDU + UC_YA + h * 64 + ch8);
        if (pass == 2) carry_in = ((const float*)(a->ws + WS_ASUM))[((size_t)(gc * 2 + (tid >> 8)) * 2 + 1) * 256 + h * 64 + ((tid >> 2) & 63)];
        if (tid < 128) { const int dir = tid >> 6, n = tid & 63, o = l * 512 + dir * 256 + h * 64 + n;
            Gp[tid] = a->in[I_LBR][o]; Gp[128 + tid] = a->in[I_LBI][o]; Gp[256 + tid] = softplusf_(-a->in[I_LLAM][o]); }
    }
    bf16x8 wl[4][2][2];
    { const bf16_t* WLp = (const bf16_t*)(a->ws + WS_LRU); const int dirw = (tid >> 6) >> 2, cc = tid & 15, qq = (tid & 63) >> 4;
#pragma unroll
      for (int ct = 0; ct < 4; ++ct)
#pragma unroll
        for (int ty = 0; ty < 2; ++ty)
#pragma unroll
          for (int kb = 0; kb < 2; ++kb) wl[ct][ty][kb] = *(const bf16x8*)(WLp + (size_t)((dirw * 2 + ty) * 4 + h) * 4096 + (16 * ct + cc) * 64 + kb * 32 + 8 * qq); }
    const float* cw = a->in[I_CAW] + l * 1024 + h * 64 + (tid & 63); const float cbv = a->in[I_CAB][l * 256 + h * 64 + (tid & 63)];
    const float cw0 = cw[0], cw1 = cw[256], cw2 = cw[512], cw3 = cw[768];
    RAW_BAR();
    {
        const int n = tid & 63;
#pragma unroll
        for (int k = 0; k < 8; ++k) { const int i = (tid >> 6) + 8 * k;
            const float acc = cbv + cw0 * bf2f(Xr[i * 72 + n]) + cw1 * bf2f(Xr[(i + 1) * 72 + n]) + cw2 * bf2f(Xr[(i + 2) * 72 + n]) + cw3 * bf2f(Xr[(i + 3) * 72 + n]);
            Xc[i * 65 + n] = acc; Xh[i * 72 + n] = (bf16_t)f2bf(acc); }
    }
    RAW_BAR();
    const int c = lane & 15, q = lane >> 4;
#pragma unroll
    for (int s = 0; s < 4; ++s) {
        const int pr = 4 * wave + s, dir = pr >> 4, tile = pr & 15, rt = tile >> 2, ct = s;
        f32x4 zr = {0.f, 0.f, 0.f, 0.f}, zi = {0.f, 0.f, 0.f, 0.f};
#pragma unroll
        for (int kb = 0; kb < 2; ++kb) {
            const bf16x8 xa = *(const bf16x8*)(Xh + (16 * rt + c) * 72 + kb * 32 + 8 * q);
            zr = mfma16(xa, wl[s][0][kb], zr);
            zi = mfma16(xa, wl[s][1][kb], zi);
        }
        const int n = 16 * ct + c;
        const float br = Gp[dir * 64 + n], bi = Gp[128 + dir * 64 + n], sp = Gp[256 + dir * 64 + n];
#pragma unroll
        for (int j = 0; j < 4; ++j) { const int i = 16 * rt + 4 * q + j;
            const float r = sigmoidf_(zr[j] + br), ig = sigmoidf_(zi[j] + bi);
            const float la = -8.f * r * sp;
            Aa[(dir * 64 + i) * 65 + n] = __expf(la);
            Bb[(dir * 64 + i) * 65 + n] = sqrtf(neg_expm1(2.f * la)) * (ig * Xc[i * 65 + n]); }
    }
    RAW_BAR();
    float* AS = (float*)(a->ws + WS_ASUM);
    {
        const int chain = tid >> 2, seg = tid & 3, dir = chain >> 6, n = chain & 63, chn = h * 64 + n;
        float* sum = AS + ((size_t)(gc * 2 + dir) * 2) * 256 + chn;
        float av[16], bv[16];
#pragma unroll
        for (int k = 0; k < 16; ++k) { const int ii = seg * 16 + k, i = dir ? 63 - ii : ii; av[k] = Aa[(dir * 64 + i) * 65 + n]; bv[k] = Bb[(dir * 64 + i) * 65 + n]; }
        float hq = 0.f, aq = 1.f;
#pragma unroll
        for (int k = 0; k < 16; ++k) { hq = av[k] * hq + bv[k]; aq *= av[k]; }
        float c = carry_in, atot = 1.f, cme = carry_in;
#pragma unroll
        for (int sg = 0; sg < 4; ++sg) {
            const float as_ = shx(aq, 0, (tid & ~3) | sg), hs_ = shx(hq, 0, (tid & ~3) | sg);
            if (seg == sg) cme = c;
            c = as_ * c + hs_; atot *= as_;
        }
        float hc = cme;
#pragma unroll
        for (int k = 0; k < 16; ++k) { const int ii = seg * 16 + k, i = dir ? 63 - ii : ii; hc = av[k] * hc + bv[k]; Bb[(dir * 64 + i) * 65 + n] = hc; }
        if (pass == 1 && !dry && seg == 0) { sum[0] = atot; sum[256] = c; }
    }
    if (pass == 2) {
        RAW_BAR();
        float y[8], o[8]; unpack8(yaw, y);
#pragma unroll
        for (int j = 0; j < 8; ++j) o[j] = (Bb[row * 65 + ch8 + j] + Bb[(64 + row) * 65 + ch8 + j]) * gelu_tanh(y[j]);
        if (!dry) *(u32x4*)(U + (size_t)(t0 + row) * LDU + UC_YA + h * 64 + ch8) = pack8(o);
    }
    RAW_BAR();
}
__device__ __forceinline__ void mixA_scan(KArgs a, int s, int tid, bool dry) {
    asm volatile("" : "+v"(tid));
    const int dir = tid >> 8, ch = tid & 255;
    const int c0 = s < 4 ? 128 * s : 512, n = s < 4 ? 128 : 256;
    float* AS = (float*)(a->ws + WS_ASUM);
    float carry = 0.f;
    for (int nb = 0; nb < n; nb += 16) {
        float av[16], bv[16];
#pragma unroll
        for (int j = 0; j < 16; ++j) { const int gc = dir ? c0 + n - 1 - (nb + j) : c0 + nb + j; const float* p = AS + ((size_t)(gc * 2 + dir) * 2) * 256 + ch; av[j] = p[0]; bv[j] = p[256]; }
#pragma unroll
        for (int j = 0; j < 16; ++j) { const int gc = dir ? c0 + n - 1 - (nb + j) : c0 + nb + j; float* p = AS + ((size_t)(gc * 2 + dir) * 2) * 256 + ch;
            if (!dry) p[256] = carry; carry = av[j] * carry + bv[j]; }
    }
}
__device__ __forceinline__ int kpos(int k) { const int x = k & 31, xx = x & 15; return (k & ~31) + ((xx >> 2) << 3) + ((x >> 4) << 2) + (xx & 3); }

__device__ __forceinline__ void mixB_local(KArgs a, int l, int gc, int h, int tid, bool dry) {
    asm volatile("" : "+s"(l));
    unsigned char* lds = lds_dyn;
    asm volatile("" : "+v"(tid));
    bf16_t* U = (bf16_t*)(a->ws + WS_U); const bf16_t* HB = (const bf16_t*)(a->ws + WS_HB);
    float* Xf = (float*)lds;
    bf16_t* Qh = (bf16_t*)(lds + 49920); bf16_t* Kh = Qh + 64 * 72;
    bf16_t* KKh = Kh + 64 * 72; bf16_t* QKh = KKh + 64 * 72;
    float* Lf = (float*)(lds + 86784);
    bf16_t* solT = (bf16_t*)(lds + 103168);
    float* Osum = (float*)(lds + 121600);
    float* bet = (float*)(lds + 138240); float* gcm = bet + 64; float* eg = gcm + 64;
    float* Bt = (float*)(lds + 139008); float* Gt = Bt + 128;
    float* Cw = (float*)(lds + 140032);
    bf16_t* Raw = (bf16_t*)(lds + 86784);
    const int lane = tid & 63, wave = tid >> 6;
    const int t0 = gc * 64, ts = seq_start_tok(t0), te = seq_end_tok(t0);
    {
        const u32x4 z4 = {0u, 0u, 0u, 0u};
#pragma unroll
        for (int it = 0; it < 4; ++it) {
            const int idx = tid + 512 * it;
            if (idx < 1608) {
                const int rr = idx / 24, pc = idx % 24, t = t0 - 2 + rr, col = (pc >> 3) * 256 + h * 64 + (pc & 7) * 8;
                u32x4 v = z4;
                if (t >= ts && t < te) {
                    if (rr < 2) v = *(const u32x4*)(HB + ((size_t)(gc - 1) * 3 + 1 + rr) * 768 + col);
                    else if (rr == 66) v = *(const u32x4*)(HB + ((size_t)(gc + 1) * 3) * 768 + col);
                    else v = *(const u32x4*)(U + (size_t)t * LDU + UC_QB + col);
                }
                *(u32x4*)(Raw + rr * 200 + (pc >> 3) * 64 + (pc & 7) * 8) = v;
            }
        }
        const float* cwg = a->in[I_GCONV] + l * 3072;
        for (int i = tid; i < 768; i += 512) { const int j = i / 192, cc = i % 192; Cw[i] = cwg[j * 768 + (cc >> 6) * 256 + h * 64 + (cc & 63)]; }
        if (tid < 128) {
            const int dir = tid >> 6, i = tid & 63, tok = t0 + (dir ? 63 - i : i);
            const float* bap = (const float*)(a->ws + WS_BA) + (size_t)tok * 16 + dir * 4 + h;
            Bt[tid] = sigmoidf_(bap[0]);
            Gt[tid] = -__expf(a->in[I_GALOG][l * 8 + dir * 4 + h]) * softplusf_(bap[8] + a->in[I_GDT][l * 8 + dir * 4 + h]);
        }
        for (int idx = tid; idx < 64 * 65; idx += 512) Osum[idx] = 0.f;
    }
    RAW_BAR();
#pragma unroll 4
    for (int idx = tid; idx < 64 * 192; idx += 512) {
        const int i = idx / 192, cc = idx % 192;
        const float acc = Cw[cc] * bf2f(Raw[i * 200 + cc]) + Cw[192 + cc] * bf2f(Raw[(i + 1) * 200 + cc]) + Cw[384 + cc] * bf2f(Raw[(i + 2) * 200 + cc]) + Cw[576 + cc] * bf2f(Raw[(i + 3) * 200 + cc]);
        Xf[((cc >> 6) * 64 + i) * 65 + (cc & 63)] = siluf_(acc);
    }
    RAW_BAR();
    {
        const int part = tid >> 8, i = (tid >> 2) & 63, sub = tid & 3; float* x = Xf + (part * 64 + i) * 65 + sub * 16; float ss = 0.f;
#pragma unroll
        for (int d = 0; d < 16; ++d) ss += x[d] * x[d];
        ss += shx(ss, 1, tid); ss += shx(ss, 2, tid);
        const float inv = (part == 0 ? 0.125f : 1.f) / sqrtf(ss + EPS);
        bf16_t* hh = (part == 0 ? Qh : Kh) + i * 72 + sub * 16;
#pragma unroll
        for (int d = 0; d < 16; ++d) { const float v = x[d] * inv; x[d] = v; hh[d] = (bf16_t)f2bf(v); }
    }
    RAW_BAR();
    const int c = lane & 15, q = lane >> 4;
    {
        const bf16_t* A = wave < 4 ? Kh : Qh; bf16_t* O = wave < 4 ? KKh : QKh;
#pragma unroll
        for (int s = 0; s < 4; ++s) { const int tile = (wave & 3) * 4 + s, rt = tile >> 2, ct = tile & 3;
            f32x4 z = {0.f, 0.f, 0.f, 0.f};
#pragma unroll
            for (int kb = 0; kb < 2; ++kb) z = mfma16(*(const bf16x8*)(A + (16 * rt + c) * 72 + kb * 32 + 8 * q), *(const bf16x8*)(Kh + (16 * ct + c) * 72 + kb * 32 + 8 * q), z);
#pragma unroll
            for (int j = 0; j < 4; ++j) O[(16 * rt + 4 * q + j) * 72 + 16 * ct + c] = (bf16_t)f2bf(z[j]); }
    }
    RAW_BAR();
    bf16_t* attnh = Qh; bf16_t* kgT = Kh;
    bf16_t* MN = (bf16_t*)(a->ws + WS_MN); float* DEC = (float*)(a->ws + WS_DEC);
#pragma unroll 1
    for (int dir = 0; dir < 2; ++dir) {
        const size_t unit = (size_t)(gc * 4 + h) * 2 + dir;
        if (tid < 64) {
            float g = Gt[dir * 64 + tid];
#pragma unroll
            for (int o = 1; o < 64; o <<= 1) { const float t = __builtin_bit_cast(float, __builtin_amdgcn_ds_bpermute(((tid - o) & 63) << 2, __builtin_bit_cast(int, g))); if (tid >= o) g += t; }
            bet[tid] = Bt[dir * 64 + tid]; gcm[tid] = g; eg[tid] = __expf(g);
            if (tid == 63 && !dry) DEC[unit] = __expf(g);
        }
        RAW_BAR();
        const float gl = gcm[63];
        for (int idx = tid; idx < 4096; idx += 512) {
            const int i = idx & 63, j = idx >> 6, ri = dir ? 63 - i : i, rj = dir ? 63 - j : j;
            Lf[j * 64 + i] = j < i ? bet[i] * bf2f(KKh[rj * 72 + ri]) * __expf(gcm[i] - gcm[j]) : 0.f;
        }
        for (int idx = tid; idx < 4096; idx += 512) {
            const int j = idx & 63, i = idx >> 6, ri = dir ? 63 - i : i, rj = dir ? 63 - j : j;
            attnh[i * 72 + j] = (bf16_t)f2bf(j <= i ? bf2f(QKh[ri * 72 + rj]) * __expf(gcm[i] - gcm[j]) : 0.f);
            kgT[i * 72 + j] = (bf16_t)f2bf(Xf[(64 + rj) * 65 + i] * __expf(gl - gcm[j]));
        }
        RAW_BAR();
        {
            const int g = lane & 3, col = wave * 16 + (lane >> 2); bf16_t* xrow = solT + col * 72;
            const float* xsrc = col < 64 ? Xf + 128 * 65 + col : Xf + 64 * 65 + (col - 64);
#pragma unroll 1
            for (int b = 0; b < 4; ++b) {
                float r[4];
#pragma unroll
                for (int e = 0; e < 4; ++e) { const int i = 16 * b + 4 * g + e, ri = dir ? 63 - i : i; r[e] = xsrc[ri * 65] * bet[i] * (col < 64 ? 1.f : eg[i]); }
#pragma unroll 1
                for (int j0 = 0; j0 < 16 * b; j0 += 8) {
                    float xv[8]; unpack8(*(const u32x4*)(xrow + j0), xv);
#pragma unroll
                    for (int jj = 0; jj < 8; ++jj) { const f32x4 lv = *(const f32x4*)(Lf + (j0 + jj) * 64 + 16 * b + 4 * g);
                        r[0] -= lv[0] * xv[jj]; r[1] -= lv[1] * xv[jj]; r[2] -= lv[2] * xv[jj]; r[3] -= lv[3] * xv[jj]; }
                }
#pragma unroll
                for (int gs = 0; gs < 4; ++gs) {
                    if (g == gs) {
                        const float* lp = Lf + (16 * b + 4 * g) * 64 + 16 * b + 4 * g;
                        r[1] -= lp[1] * r[0];
                        r[2] -= lp[2] * r[0] + lp[64 + 2] * r[1];
                        r[3] -= lp[3] * r[0] + lp[64 + 3] * r[1] + lp[128 + 3] * r[2];
                    }
                    if (gs < 3) {
                        float xp[4];
#pragma unroll
                        for (int e = 0; e < 4; ++e) xp[e] = __builtin_bit_cast(float, __builtin_amdgcn_ds_bpermute((((tid & ~3) | gs) & 63) << 2, __builtin_bit_cast(int, r[e])));
                        if (g > gs) {
#pragma unroll
                            for (int pp = 0; pp < 4; ++pp) { const f32x4 lv = *(const f32x4*)(Lf + (16 * b + 4 * gs + pp) * 64 + 16 * b + 4 * g);
                                r[0] -= lv[0] * xp[pp]; r[1] -= lv[1] * xp[pp]; r[2] -= lv[2] * xp[pp]; r[3] -= lv[3] * xp[pp]; }
                        }
                    }
                }
                u32x2 wv2; wv2.x = pk2(r[0], r[1]); wv2.y = pk2(r[2], r[3]);
                *(u32x2*)(xrow + 16 * b + 4 * g) = wv2;
            }
        }
        RAW_BAR();
        {
            const int rt = wave & 3; const bf16_t* A = wave < 4 ? attnh : kgT;
            const bf16x8 a0 = *(const bf16x8*)(A + (16 * rt + c) * 72 + 8 * q), a1 = *(const bf16x8*)(A + (16 * rt + c) * 72 + 32 + 8 * q);
#pragma unroll 1
            for (int ct = 0; ct < 8; ++ct) {
                f32x4 z = {0.f, 0.f, 0.f, 0.f};
                z = mfma16(a0, *(const bf16x8*)(solT + (16 * ct + c) * 72 + 8 * q), z);
                z = mfma16(a1, *(const bf16x8*)(solT + (16 * ct + c) * 72 + 32 + 8 * q), z);
                if (wave < 4) {
                    if (ct < 4) {
#pragma unroll
                        for (int j = 0; j < 4; ++j) { const int i = 16 * rt + 4 * q + j, ri = dir ? 63 - i : i; Osum[ri * 65 + 16 * ct + c] += z[j]; }
                    } else {
                        const int dk = 16 * (ct - 4) + c, pp = kpos(dk);
#pragma unroll
                        for (int j = 0; j < 4; ++j) { const int i = 16 * rt + 4 * q + j, ri = dir ? 63 - i : i;
                            const bf16_t ov = (bf16_t)f2bf(Xf[ri * 65 + dk] * eg[i] - z[j]); if (!dry) U[(size_t)(t0 + ri) * LDU + (dir ? UC_KB : UC_QB) + h * 64 + pp] = ov; }
                    }
                } else {
                    if (ct < 4) {
                        u32x2 w; w.x = pk2(z[0], z[1]); w.y = pk2(z[2], z[3]);
                        if (!dry) *(u32x2*)(MN + unit * 8192 + 4096 + (16 * ct + c) * 64 + 16 * rt + 4 * q) = w;
                    } else {
                        const int pp = kpos(16 * (ct - 4) + c);
#pragma unroll
                        for (int j = 0; j < 4; ++j) if (!dry) MN[unit * 8192 + (16 * rt + 4 * q + j) * 64 + pp] = (bf16_t)f2bf(z[j]);
                    }
                }
            }
        }
        RAW_BAR();
    }
    { const int row = tid >> 3, ch8 = (tid & 7) * 8; if (!dry) *(u32x4*)(U + (size_t)(t0 + row) * LDU + UC_VB + h * 64 + ch8) = pack8(Osum + row * 65 + ch8); }
    RAW_BAR();
}

__device__ __forceinline__ void mixB_chain(KArgs a, int s, int h, int dir, int tid, bool dry) {
    unsigned char* lds = lds_dyn;
    asm volatile("" : "+v"(tid));
    bf16_t* U = (bf16_t*)(a->ws + WS_U);
    const bf16_t* MN = (const bf16_t*)(a->ws + WS_MN); const float* DEC = (const float*)(a->ws + WS_DEC);
    const int lane = tid & 63, wave = tid >> 6, w = wave & 3, hf = wave >> 2, c = lane & 15, q = lane >> 4;
    const int c0 = s < 4 ? 128 * s : 512, n = s < 4 ? 128 : 256;
    const int slot = (dir ? UC_KB : UC_QB) + h * 64;
    bf16_t* Sbuf = (bf16_t*)lds;
    for (int i = tid; i < 2 * 64 * 72 / 2; i += 512) ((unsigned*)Sbuf)[i] = 0u;
    constexpr int PFD = 4;
    f32x4 S[2];
    S[0] = (f32x4){0.f, 0.f, 0.f, 0.f}; S[1] = (f32x4){0.f, 0.f, 0.f, 0.f};
    bf16x8 Mq[PFD][2], Qq[PFD][2]; u32x2 Nq[PFD][2]; float dq[PFD];
    const int irow = 16 * w + c, rirow = dir ? 63 - irow : irow;
#define MIXB_LOAD(k, step) do { const int gc_ = dir ? c0 + n - 1 - (step) : c0 + (step); const size_t unit_ = (size_t)(gc_ * 4 + h) * 2 + dir; const bf16_t* Mp = MN + unit_ * 8192; \
        _Pragma("unroll") for (int kb = 0; kb < 2; ++kb) { Mq[k][kb] = *(const bf16x8*)(Mp + irow * 64 + kb * 32 + 8 * q); \
            Qq[k][kb] = *(const bf16x8*)(U + (size_t)(gc_ * 64 + rirow) * LDU + slot + kb * 32 + 8 * q); } \
        _Pragma("unroll") for (int t = 0; t < 2; ++t) Nq[k][t] = *(const u32x2*)(Mp + 4096 + (16 * (2 * hf + t) + c) * 64 + 16 * w + 4 * q); \
        dq[k] = DEC[unit_]; } while (0)
#pragma unroll
    for (int k = 0; k < PFD; ++k) MIXB_LOAD(k, k);
    RAW_BAR();
#pragma unroll 1
    for (int step0 = 0; step0 < n; step0 += PFD) {
#pragma unroll
        for (int k = 0; k < PFD; ++k) {
            const int step = step0 + k, p = k & 1;
            const bf16_t* Sr = Sbuf + p * (64 * 72); bf16_t* Sw = Sbuf + (p ^ 1) * (64 * 72);
            bf16x8 Sf[2][2];
#pragma unroll
            for (int t = 0; t < 2; ++t)
#pragma unroll
                for (int kb = 0; kb < 2; ++kb) Sf[t][kb] = *(const bf16x8*)(Sr + (16 * (2 * hf + t) + c) * 72 + 32 * kb + 8 * q);
            f32x4 cr[2];
#pragma unroll
            for (int t = 0; t < 2; ++t) {
                f32x4 ns = {0.f, 0.f, 0.f, 0.f}, z = {0.f, 0.f, 0.f, 0.f};
                ns = mfma16(Mq[k][0], Sf[t][0], ns); ns = mfma16(Mq[k][1], Sf[t][1], ns);
                z = mfma16(Sf[t][0], Qq[k][0], z); cr[t] = mfma16(Sf[t][1], Qq[k][1], z);
                const f32x4 nn = {bflo(Nq[k][t].x), bfhi(Nq[k][t].x), bflo(Nq[k][t].y), bfhi(Nq[k][t].y)};
                S[t] = S[t] * dq[k] - ns + nn;
                u32x2 sw; sw.x = pg8::cvt_pk_bf16(S[t][0], S[t][1]); sw.y = pg8::cvt_pk_bf16(S[t][2], S[t][3]);
                *(u32x2*)(Sw + (16 * (2 * hf + t) + c) * 72 + 32 * (w >> 1) + 8 * q + 4 * (w & 1)) = sw;
            }
            u32x2 cp[2];
#pragma unroll
            for (int t = 0; t < 2; ++t) { cp[t].x = pg8::cvt_pk_bf16(cr[t][0], cr[t][1]); cp[t].y = pg8::cvt_pk_bf16(cr[t][2], cr[t][3]); asm volatile("" :: "v"(cp[t].x), "v"(cp[t].y)); }
            const int gc = dir ? c0 + n - 1 - step : c0 + step;
            if (step + PFD < n) MIXB_LOAD(k, step + PFD);
            RAW_BAR();
#pragma unroll
            for (int t = 0; t < 2; ++t) if (!dry) *(u32x2*)(U + (size_t)(gc * 64 + rirow) * LDU + slot + 16 * (2 * hf + t) + 4 * q) = cp[t];
        }
    }
#undef MIXB_LOAD
    RAW_BAR();
}
__device__ __forceinline__ void mixB_final(KArgs a, int l, int gc, int h, int tid, bool dry) {
    asm volatile("" : "+s"(l));
    asm volatile("" : "+v"(tid));
    bf16_t* U = (bf16_t*)(a->ws + WS_U);
    const int i = tid >> 3, e0 = (tid & 7) * 8; const float* gn = a->in[I_GNORM] + l * 64;
    bf16_t* row = U + (size_t)(gc * 64 + i) * LDU + h * 64 + e0;
    float v[8], f[8], b[8], zz[8];
    unpack8(*(const u32x4*)(row + UC_VB), v); unpack8(*(const u32x4*)(row + UC_QB), f); unpack8(*(const u32x4*)(row + UC_KB), b); unpack8(*(const u32x4*)(row + UC_ZB), zz);
    float ss = 0.f;
#pragma unroll
    for (int j = 0; j < 8; ++j) { v[j] += f[j] + b[j]; ss += v[j] * v[j]; }
    ss += shx(ss, 1, tid); ss += shx(ss, 2, tid); ss += shx(ss, 4, tid);
    const float r = 1.f / sqrtf(ss * (1.f / 64.f) + EPS);
#pragma unroll
    for (int j = 0; j < 8; ++j) v[j] = v[j] * r * gn[e0 + j] * siluf_(zz[j]);
    if (!dry) *(u32x4*)(row + UC_ZB) = pack8(v);
}

#ifndef MIX_MASK
#define MIX_MASK 15
#endif
#ifndef DRY_L2
#define DRY_L2 0
#endif
#ifndef DRY_L3
#define DRY_L3 0
#endif
#ifndef DRY_L4
#define DRY_L4 0
#endif
__device__ __forceinline__ bool opaque_flag(int v) { asm volatile("" : "+s"(v)); return v != 0; }
__device__ __forceinline__ void phase_mix_local(int wv, int l) {
    asm volatile("" : "+s"(l));
    unsigned char* lds = lds_dyn;
    KArgs a = kargs();
    const int tid = tidx(wv), bid = bidx(), gd = gdim();
    for (int rep = (DRY_L2 ? 0 : 1); rep < 2; ++rep) {
        const bool dry = opaque_flag(rep == 0); const int dm = dry ? DRY_L2 : 15;
        for (int job = bid; job < 4 * 3072; job += gd) {
            const int ty = job / 3072, r = job % 3072, gc = r >> 2, h = r & 3;
            if (ty == 0) { }
            else if (ty == 1) { if ((MIX_MASK & 4) && (dm & 2)) mixC_local(a, l, gc, h, tid, dry); }
            else if (ty == 2) { if ((MIX_MASK & 1) && (dm & 4)) mixA_job(a, l, gc, h, 1, tid, dry); }
            else { if ((MIX_MASK & 2) && (dm & 8)) mixB_local(a, l, gc, h, tid, dry); }
        }
    }
}
__device__ __forceinline__ void phase_mix_scan(int wv, int l) {
    asm volatile("" : "+s"(l));
    unsigned char* lds = lds_dyn;
    KArgs a = kargs();
    const int tid = tidx(wv), bid = bidx(), gd = gdim();
    for (int rep = (DRY_L3 ? 0 : 1); rep < 2; ++rep) {
        const bool dry = opaque_flag(rep == 0); const int dm = dry ? DRY_L3 : 7;
        for (int job = bid; job < 205; job += gd) {
            if (job < 40) { if ((MIX_MASK & 2) && (dm & 1)) mixB_chain(a, job >> 3, (job >> 1) & 3, job & 1, tid, dry); }
            else if (job < 45) { if ((MIX_MASK & 1) && (dm & 2)) mixA_scan(a, job - 40, tid, dry); }
            else { if ((MIX_MASK & 4) && (dm & 4)) mixC_scan(a, l, job - 45, tid, dry); }
        }
        if (!dry && (MIX_MASK & 8) && bid >= 40 && gd > 40) {
            for (int d = bid - 40; d < 3072; d += gd - 40) mixD_job(a, l, d >> 2, d & 3, tid, false);
            RAW_BAR();
            phase_weights(wv, l, 2, 40);
        }
    }
}
__device__ __forceinline__ void phase_mix_final(int wv, int l) {
    asm volatile("" : "+s"(l));
    unsigned char* lds = lds_dyn;
    KArgs a = kargs();
    const int tid = tidx(wv), bid = bidx(), gd = gdim();
    bf16_t* U = (bf16_t*)(a->ws + WS_U);
    for (int rep = (DRY_L4 ? 0 : 1); rep < 2; ++rep) {
        const bool dry = opaque_flag(rep == 0); const int dm = dry ? DRY_L4 : 7;
        for (int job = bid; job < 3 * 3072; job += gd) {
            const int ty = job / 3072, r = job % 3072, gc = r >> 2, h = r & 3;
            if (ty == 0) { if ((MIX_MASK & 4) && (dm & 1)) mixC_final(a, l, gc, h, tid, dry); }
            else if (ty == 1) { if ((MIX_MASK & 1) && (dm & 2)) mixA_job(a, l, gc, h, 2, tid, dry); }
            else { if ((MIX_MASK & 2) && (dm & 4)) mixB_final(a, l, gc, h, tid, dry); }
        }
    }
    for (int m = 0; m < 4; ++m) {
        const int bit = m == 0 ? 1 : (m == 1 ? 2 : (m == 2 ? 4 : 8));
        if (MIX_MASK & bit) continue;
        for (int idx = bid * 512 + tid; idx < M_TOK * 32; idx += gd * 512) { const int t = idx >> 5, c8 = (idx & 31) * 8; *(u32x4*)(U + (size_t)t * LDU + m * 256 + c8) = (u32x4){0u, 0u, 0u, 0u}; }
    }
}
#ifndef MIX_MASK
#define MIX_MASK 15
#endif
__global__ void __launch_bounds__(512, 2) fwd_megakernel(Args a) {
    unsigned nbar = 0u;
    int wv = __builtin_amdgcn_readfirstlane(threadIdx.x >> 6);

    for (int l = 0; l < 2; ++l) {
        phase_weights(wv, l, 1);
        phase_norm(wv, l, (l == 0 ? 1 : 0) | 2);
        if (l == 0) GSYNC_CG(); else GSYNC();
        { KArgs ka = kargs(); unsigned char* ws = ka->ws; int G = gridDim.x, bx = blockIdx.x; asm volatile("" : "+s"(G), "+s"(bx)); bf16_t* U = (bf16_t*)(ws + WS_U); bf16_t* XB = (bf16_t*)(ws + WS_XB); float* RS = (float*)(ws + WS_RS); (void)U; (void)XB; (void)RS;
          pg8::Gemm g{XB, (const bf16_t*)(ws + WS_WIN), M_TOK, LDU, DM, DM}; pg8::StaticOrder S; S.init(M_TOK, LDU, G, bx);
          pg8::EpiU E{U, RS, (bf16_t*)(ws + WS_HB)};
          pg8::gemm_phase<pg8::EpiU, pg8::StaticOrder, true>((PG8_LAS unsigned char*)lds_dyn, g, S, E, tidx(wv)); }
        GSYNC();
#if MIX_MASK
        phase_mix_local(wv, l);
        GSYNC();
        phase_mix_scan(wv, l);
        GSYNC();
        phase_mix_final(wv, l);
        GSYNC();
        { KArgs ka = kargs(); unsigned char* ws = ka->ws; int G = gridDim.x, bx = blockIdx.x; asm volatile("" : "+s"(G), "+s"(bx)); bf16_t* U = (bf16_t*)(ws + WS_U); bf16_t* XB = (bf16_t*)(ws + WS_XB); float* RS = (float*)(ws + WS_RS); (void)U; (void)XB; (void)RS;
          pg8::Gemm g{U, (const bf16_t*)(ws + WS_WOUT), M_TOK, DM, DM, LDU}; pg8::StaticOrder S; S.init(M_TOK, DM, G, bx);
          pg8::EpiResN E{ka->out, XB, (float*)(ws + WS_SS2), l == 0 ? ka->in[I_XP] : nullptr, ka->in[I_XS]};
          pg8::gemm_phase<pg8::EpiResN, pg8::StaticOrder, true>((PG8_LAS unsigned char*)lds_dyn, g, S, E, tidx(wv)); }
        GSYNC();
#endif
        for (int hf = 0; hf < 3; ++hf) {
            const int row0 = hf * MH;
            { KArgs ka = kargs(); unsigned char* ws = ka->ws; int G = gridDim.x, bx = blockIdx.x; asm volatile("" : "+s"(G), "+s"(bx)); bf16_t* U = (bf16_t*)(ws + WS_U); bf16_t* XB = (bf16_t*)(ws + WS_XB); float* RS = (float*)(ws + WS_RS); (void)U; (void)XB; (void)RS;
              pg8::Gemm g{XB + (size_t)row0 * DM, (const bf16_t*)(ws + WS_WGU), MH, 2 * DFF, DM, DM}; pg8::StaticOrder S; S.init(MH, 2 * DFF, G, bx);
              pg8::EpiGU E{(bf16_t*)(ws + WS_G), (bf16_t*)(ws + WS_UP), RS + row0, (const float*)(ws + WS_SS2) + (size_t)row0 * 16};
              pg8::gemm_phase<pg8::EpiGU, pg8::StaticOrder, true>((PG8_LAS unsigned char*)lds_dyn, g, S, E, tidx(wv)); }
            GSYNC();
            phase_ffn_elem(wv, l, row0);
            if (hf == 2) phase_pconv(wv, l);
            GSYNC();
            { KArgs ka = kargs(); unsigned char* ws = ka->ws; int G = gridDim.x, bx = blockIdx.x; asm volatile("" : "+s"(G), "+s"(bx)); bf16_t* U = (bf16_t*)(ws + WS_U); bf16_t* XB = (bf16_t*)(ws + WS_XB); float* RS = (float*)(ws + WS_RS); (void)U; (void)XB; (void)RS;
              pg8::Gemm g{(const bf16_t*)(ws + WS_UP), (const bf16_t*)(ws + WS_WD), MH, DM, DFF, DFF}; pg8::StaticOrder S; S.init(MH, DM, G, bx);
              pg8::EpiResN E{ka->out + (size_t)row0 * DM, XB + (size_t)row0 * DM, (float*)(ws + WS_SS3) + (size_t)row0 * 16, nullptr, nullptr};
              pg8::gemm_phase<pg8::EpiResN, pg8::StaticOrder, true>((PG8_LAS unsigned char*)lds_dyn, g, S, E, tidx(wv)); }
            if (hf == 2) {
              KArgs ka = kargs(); unsigned char* ws = ka->ws; int G = gridDim.x, bx = blockIdx.x; asm volatile("" : "+s"(G), "+s"(bx)); bf16_t* U = (bf16_t*)(ws + WS_U); bf16_t* XB = (bf16_t*)(ws + WS_XB); float* RS = (float*)(ws + WS_RS); (void)U; (void)XB; (void)RS;
              pg8::Gemm g{(const bf16_t*)(ws + WS_PB), (const bf16_t*)(ws + WS_WPP), M_TOK, DM, PLED, PLED}; pg8::StaticOrder S; S.init(M_TOK, DM, G, bx);
              pg8::EpiP E{(bf16_t*)(ws + WS_P)};
              pg8::gemm_phase<pg8::EpiP, pg8::StaticOrder, true>((PG8_LAS unsigned char*)lds_dyn, g, S, E, tidx(wv)); }
            GSYNC();
        }
        { KArgs ka = kargs(); unsigned char* ws = ka->ws; int G = gridDim.x, bx = blockIdx.x; asm volatile("" : "+s"(G), "+s"(bx)); bf16_t* U = (bf16_t*)(ws + WS_U); bf16_t* XB = (bf16_t*)(ws + WS_XB); float* RS = (float*)(ws + WS_RS); (void)U; (void)XB; (void)RS;
          pg8::Gemm g{XB, (const bf16_t*)(ws + WS_WPG), M_TOK, DM, DM, DM}; pg8::StaticOrder S; S.init(M_TOK, DM, G, bx);
          pg8::EpiPle E{ka->out, (const bf16_t*)(ws + WS_P), RS, (const float*)(ws + WS_SS3)};
          pg8::gemm_phase<pg8::EpiPle, pg8::StaticOrder, true>((PG8_LAS unsigned char*)lds_dyn, g, S, E, tidx(wv)); }
        if (l == 0) GSYNC();
    }
}

extern "C" void kernel_launch(void* const* d_in, const int* in_sizes, int n_in, void* d_out, int out_size, void* d_ws, size_t ws_size, hipStream_t stream) {
    static int grid = 0;
    if (grid == 0) {
        if (n_in != 32 || out_size != M_TOK * DM || ws_size < WS_END) { fprintf(stderr, "kernel_launch: unexpected problem (n_in %d out %d ws %zu, need %zu)\n", n_in, out_size, ws_size, (size_t)WS_END); grid = -1; return; }
        int dev = 0, cus = 0, per_cu = 0;
        hipGetDevice(&dev); hipDeviceGetAttribute(&cus, hipDeviceAttributeMultiprocessorCount, dev);
        if (hipFuncSetAttribute((const void*)fwd_megakernel, hipFuncAttributeMaxDynamicSharedMemorySize, LDS_BYTES) != hipSuccess) { fprintf(stderr, "kernel_launch: hipFuncSetAttribute failed\n"); grid = -1; return; }
        if (hipOccupancyMaxActiveBlocksPerMultiprocessor(&per_cu, (const void*)fwd_megakernel, 512, LDS_BYTES) != hipSuccess || per_cu < 1) { fprintf(stderr, "kernel_launch: occupancy query says %d\n", per_cu); per_cu = 1; }
        (void)hipGetLastError();
        grid = cus * 1;
    }
    if (grid < 0) return;
    if (hipMemsetAsync((char*)d_ws + WS_BAR, 0, 256, stream) != hipSuccess) { fprintf(stderr, "kernel_launch: hipMemsetAsync failed\n"); return; }
    Args a{};
    for (int i = 0; i < 32; ++i) a.in[i] = (const float*)d_in[i];
    a.out = (float*)d_out; a.ws = (unsigned char*)d_ws;
    void* args[] = {&a};
    hipError_t e = hipLaunchCooperativeKernel((const void*)fwd_megakernel, dim3(grid), dim3(512), args, LDS_BYTES, stream);
    if (e != hipSuccess) fprintf(stderr, "cooperative launch failed: %s (grid %d)\n", hipGetErrorString(e), grid);
}
```
